# Optimizing an MI355X kernel written in HIP

```python
import math
import jax, jax.numpy as jnp
from jax import lax
import numpy as np


D_MODEL = 1024
BATCH = 2
SEQ = 8192
DEPTH = 1

MIX_WIDTH = D_MODEL
HEAD_DIM = 64
ATTN_HEADS = (MIX_WIDTH // 2) // HEAD_DIM
ATTN_WIDTH = ATTN_HEADS * HEAD_DIM
SSM_GROUP_CH = 16
SSM_GROUPS = (MIX_WIDTH - ATTN_WIDTH) // SSM_GROUP_CH
SSM_WIDTH = SSM_GROUPS * SSM_GROUP_CH
SSM_STATE = 64
DT_MIN = 1e-3
DT_MAX = 1e-1
MOBA_BLOCK = 256
MOBA_TOPK = 3
QUERY_CHUNK = 128
ROPE_THETA = 10000.0
D_FF = 4 * D_MODEL
EPS = 1e-6
IN_PROJ_WIDTH = 3 * ATTN_WIDTH + SSM_WIDTH

kernel_name = 'hymba_moba_s5_hybrid_layer'


def rmsnorm(x, g):
    xf = x.astype(jnp.float32)
    y = xf * lax.rsqrt(jnp.mean(jnp.square(xf), axis=-1, keepdims=True) + EPS)
    return (y * g.astype(jnp.float32)).astype(x.dtype)


def rope(x):
    L = x.shape[2]
    half = HEAD_DIM // 2
    inv_freq = ROPE_THETA ** (-jnp.arange(half, dtype=jnp.float32) / half)
    ang = jnp.arange(L, dtype=jnp.float32)[:, None] * inv_freq[None, :]
    cos, sin = jnp.cos(ang), jnp.sin(ang)
    xf = x.astype(jnp.float32)
    x1, x2 = xf[..., :half], xf[..., half:]
    out = jnp.concatenate([x1 * cos - x2 * sin, x1 * sin + x2 * cos], axis=-1)
    return out.astype(x.dtype)


def moba_attention(q, k, v):
    B, H, L, D = q.shape
    nb = -(-L // MOBA_BLOCK)
    pad = nb * MOBA_BLOCK - L
    kp = jnp.pad(k, ((0, 0), (0, 0), (0, pad), (0, 0)))
    vp = jnp.pad(v, ((0, 0), (0, 0), (0, pad), (0, 0)))
    k_blk = kp.reshape(B, H, nb, MOBA_BLOCK, D)
    v_blk = vp.reshape(B, H, nb, MOBA_BLOCK, D)
    counts = jnp.clip(L - jnp.arange(nb) * MOBA_BLOCK, 1, MOBA_BLOCK).astype(jnp.float32)
    k_mean = k_blk.astype(jnp.float32).sum(axis=3) / counts[:, None]
    gate = jnp.einsum('bhld,bhnd->bhln', q.astype(jnp.float32), k_mean)
    q_blk_id = jnp.arange(L) // MOBA_BLOCK
    fully_past = jnp.arange(nb)[None, :] < q_blk_id[:, None]
    gate = jnp.where(fully_past, gate, -jnp.inf)
    topk = min(MOBA_TOPK, nb)
    _, sel = lax.top_k(gate, topk)
    sel_valid = sel < q_blk_id[None, None, :, None]

    scale = HEAD_DIM ** -0.5
    n_chunks = L // QUERY_CHUNK
    b_idx = jnp.arange(B)[:, None, None, None]
    h_idx = jnp.arange(H)[None, :, None, None]

    def one_chunk(ci):
        start = ci * QUERY_CHUNK
        qc = lax.dynamic_slice_in_dim(q, start, QUERY_CHUNK, axis=2)
        sc = lax.dynamic_slice_in_dim(sel, start, QUERY_CHUNK, axis=2)
        vc = lax.dynamic_slice_in_dim(sel_valid, start, QUERY_CHUNK, axis=2)
        own = start // MOBA_BLOCK
        k_sel = k_blk[b_idx, h_idx, sc]
        v_sel = v_blk[b_idx, h_idx, sc]
        k_own = lax.dynamic_index_in_dim(k_blk, own, axis=2, keepdims=False)
        v_own = lax.dynamic_index_in_dim(v_blk, own, axis=2, keepdims=False)
        s_sel = jnp.einsum('bhqd,bhqtkd->bhqtk', qc, k_sel,
                           preferred_element_type=jnp.float32) * scale
        s_sel = jnp.where(vc[..., None], s_sel, -jnp.inf).reshape(B, H, QUERY_CHUNK, topk * MOBA_BLOCK)
        s_own = jnp.einsum('bhqd,bhkd->bhqk', qc, k_own,
                           preferred_element_type=jnp.float32) * scale
        q_pos = start + jnp.arange(QUERY_CHUNK)
        k_pos = own * MOBA_BLOCK + jnp.arange(MOBA_BLOCK)
        s_own = jnp.where(k_pos[None, :] <= q_pos[:, None], s_own, -jnp.inf)
        p = jax.nn.softmax(jnp.concatenate([s_sel, s_own], axis=-1), axis=-1)
        p_sel = p[..., :topk * MOBA_BLOCK].reshape(B, H, QUERY_CHUNK, topk, MOBA_BLOCK).astype(v.dtype)
        p_own = p[..., topk * MOBA_BLOCK:].astype(v.dtype)
        return (jnp.einsum('bhqtk,bhqtkd->bhqd', p_sel, v_sel)
                + jnp.einsum('bhqk,bhkd->bhqd', p_own, v_own))

    outs = lax.map(one_chunk, jnp.arange(n_chunks))
    return outs.transpose(1, 2, 0, 3, 4).reshape(B, H, L, D)


def s5_mixer(u, lam_re, lam_im, log_dt, b_re, b_im, c_re, c_im, d_skip, w_glu, b_glu):
    Bsz, L, _ = u.shape
    uf = u.astype(jnp.float32).reshape(Bsz, L, SSM_GROUPS, SSM_GROUP_CH)
    lam = lax.complex(lam_re.astype(jnp.float32), lam_im.astype(jnp.float32))
    dt = jnp.exp(log_dt.astype(jnp.float32))[:, None]
    lam_bar = jnp.exp(lam * dt)
    b_mat = lax.complex(b_re.astype(jnp.float32), b_im.astype(jnp.float32))
    b_bar = ((lam_bar - 1.0) / lam)[..., None] * b_mat
    bu = jnp.einsum('gpn,blgn->blgp', b_bar, uf.astype(jnp.complex64))
    a = jnp.broadcast_to(lam_bar, bu.shape)

    def combine(e1, e2):
        a1, x1 = e1
        a2, x2 = e2
        return a1 * a2, a2 * x1 + x2

    _, states = lax.associative_scan(combine, (a, bu), axis=1)
    c_mat = lax.complex(c_re.astype(jnp.float32), c_im.astype(jnp.float32))
    y = jnp.einsum('gnp,blgp->blgn', c_mat, states).real + d_skip.astype(jnp.float32) * uf
    y = jax.nn.gelu(y.reshape(Bsz, L, SSM_WIDTH))
    y = y * jax.nn.sigmoid(y @ w_glu.astype(jnp.float32) + b_glu.astype(jnp.float32))
    return y.astype(u.dtype)


def setup_inputs(seed: int = 0) -> dict:
    key = jax.random.key(seed)
    ks = jax.random.split(key, 24)
    f32 = jnp.float32

    def nrm(k, shape, s):
        return s * jax.random.normal(k, shape, f32)

    n_idx = jnp.arange(SSM_STATE, dtype=f32)
    x = jax.random.normal(ks[0], (BATCH, SEQ, D_MODEL), f32)
    c = jax.random.normal(ks[1], (BATCH, D_MODEL), f32)
    w_ada = nrm(ks[2], (DEPTH, D_MODEL, 6 * D_MODEL), 0.5 * D_MODEL ** -0.5)
    b_ada = nrm(ks[3], (DEPTH, 6 * D_MODEL), 0.01)
    g_mix = 1.0 + nrm(ks[4], (DEPTH, D_MODEL), 0.02)
    w_in = nrm(ks[5], (DEPTH, D_MODEL, IN_PROJ_WIDTH), D_MODEL ** -0.5)
    g_attn_out = 1.0 + nrm(ks[6], (DEPTH, ATTN_WIDTH), 0.02)
    lam_re = -0.5 + nrm(ks[7], (DEPTH, SSM_GROUPS, SSM_STATE), 0.01)
    lam_im = math.pi * n_idx + nrm(ks[8], (DEPTH, SSM_GROUPS, SSM_STATE), 0.01)
    log_dt = jax.random.uniform(ks[9], (DEPTH, SSM_GROUPS), f32, math.log(DT_MIN), math.log(DT_MAX))
    b_re = nrm(ks[10], (DEPTH, SSM_GROUPS, SSM_STATE, SSM_GROUP_CH), (2 * SSM_GROUP_CH) ** -0.5)
    b_im = nrm(ks[11], (DEPTH, SSM_GROUPS, SSM_STATE, SSM_GROUP_CH), (2 * SSM_GROUP_CH) ** -0.5)
    c_re = nrm(ks[12], (DEPTH, SSM_GROUPS, SSM_GROUP_CH, SSM_STATE), SSM_STATE ** -0.5)
    c_im = nrm(ks[13], (DEPTH, SSM_GROUPS, SSM_GROUP_CH, SSM_STATE), SSM_STATE ** -0.5)
    d_skip = nrm(ks[14], (DEPTH, SSM_GROUPS, SSM_GROUP_CH), 1.0)
    w_glu = nrm(ks[15], (DEPTH, SSM_WIDTH, SSM_WIDTH), SSM_WIDTH ** -0.5)
    b_glu = nrm(ks[16], (DEPTH, SSM_WIDTH), 0.01)
    g_ssm_out = 1.0 + nrm(ks[17], (DEPTH, SSM_WIDTH), 0.02)
    w_out = nrm(ks[18], (DEPTH, MIX_WIDTH, D_MODEL), MIX_WIDTH ** -0.5)
    g_mlp = 1.0 + nrm(ks[19], (DEPTH, D_MODEL), 0.02)
    w_fc1 = nrm(ks[20], (DEPTH, D_MODEL, D_FF), D_MODEL ** -0.5)
    w_fc2 = nrm(ks[21], (DEPTH, D_FF, D_MODEL), D_FF ** -0.5)
    g_final = 1.0 + nrm(ks[22], (D_MODEL,), 0.02)
    return {'x': x, 'c': c, 'w_ada': w_ada, 'b_ada': b_ada, 'g_mix': g_mix, 'w_in': w_in,
            'g_attn_out': g_attn_out, 'lam_re': lam_re, 'lam_im': lam_im, 'log_dt': log_dt,
            'b_re': b_re, 'b_im': b_im, 'c_re': c_re, 'c_im': c_im, 'd_skip': d_skip,
            'w_glu': w_glu, 'b_glu': b_glu, 'g_ssm_out': g_ssm_out, 'w_out': w_out,
            'g_mlp': g_mlp, 'w_fc1': w_fc1, 'w_fc2': w_fc2, 'g_final': g_final}


def reference(x, c, w_ada, b_ada, g_mix, w_in, g_attn_out, lam_re, lam_im, log_dt,
              b_re, b_im, c_re, c_im, d_skip, w_glu, b_glu, g_ssm_out, w_out,
              g_mlp, w_fc1, w_fc2, g_final):
    Bsz, L, _ = x.shape

    def to_heads(t):
        return t.reshape(Bsz, L, ATTN_HEADS, HEAD_DIM).transpose(0, 2, 1, 3)

    for l in range(DEPTH):
        mod = jax.nn.silu(c) @ w_ada[l] + b_ada[l]
        sh1, sc1, gt1, sh2, sc2, gt2 = [m[:, None, :] for m in jnp.split(mod, 6, axis=-1)]

        h = rmsnorm(x, g_mix[l]) * (1.0 + sc1) + sh1
        proj = h @ w_in[l]
        q, k, v, u = jnp.split(proj, [ATTN_WIDTH, 2 * ATTN_WIDTH, 3 * ATTN_WIDTH], axis=-1)
        q = rope(to_heads(q))
        k = rope(to_heads(k))
        attn = moba_attention(q, k, to_heads(v)).transpose(0, 2, 1, 3).reshape(Bsz, L, ATTN_WIDTH)
        ssm = s5_mixer(u, lam_re[l], lam_im[l], log_dt[l], b_re[l], b_im[l], c_re[l], c_im[l],
                       d_skip[l], w_glu[l], b_glu[l])
        mix = jnp.concatenate([rmsnorm(attn, g_attn_out[l]), rmsnorm(ssm, g_ssm_out[l])], axis=-1)
        x = x + gt1 * (mix @ w_out[l])

        h = rmsnorm(x, g_mlp[l]) * (1.0 + sc2) + sh2
        x = x + gt2 * (jnp.square(jax.nn.relu(h @ w_fc1[l])) @ w_fc2[l])

    return rmsnorm(x, g_final)
```

```cpp
#include <hip/hip_runtime.h>
#include <hip/hip_bf16.h>
#include <cstdio>
#include <cstdint>

namespace nv {
constexpr int B = 2, L = 8192, D = 1024, M = B * L, H = 8, HD = 64, AW = 512, G = 32, GC = 16, P = 64, SW = 512, FF = 4096, NB = 32, BLK = 256;
constexpr float EPS = 1e-6f;

__device__ __forceinline__ float wsum(float v) {
#pragma unroll
    for (int o = 32; o > 0; o >>= 1) v += __shfl_xor(v, o);
    return v;
}
__device__ __forceinline__ float wmax(float v) {
#pragma unroll
    for (int o = 32; o > 0; o >>= 1) v = fmaxf(v, __shfl_xor(v, o));
    return v;
}
__device__ __forceinline__ float gelu_tanh(float x) { const float c = 0.7978845608028654f; return 0.5f * x * (1.f + tanhf(c * (x + 0.044715f * x * x * x))); }
__device__ __forceinline__ float sigmoidf_(float x) { return 1.f / (1.f + expf(-x)); }

__global__ void k_mod(const float* c, const float* w_ada, const float* b_ada, float* mod) {
    const int n = blockIdx.x * blockDim.x + threadIdx.x; if (n >= 6 * D) return;
    float a0 = 0.f, a1 = 0.f;
    for (int k = 0; k < D; ++k) { const float w = w_ada[(size_t)k * 6 * D + n]; const float c0 = c[k], c1 = c[D + k];
        a0 += (c0 / (1.f + expf(-c0))) * w; a1 += (c1 / (1.f + expf(-c1))) * w; }
    mod[n] = a0 + b_ada[n]; mod[6 * D + n] = a1 + b_ada[n];
}
__global__ void k_rmsmod(const float* in, const float* g, const float* sc, const float* sh, float* out, int ncol, int in_ld, int out_ld, int out_off) {
    const int wave = (blockIdx.x * blockDim.x + threadIdx.x) >> 6, lane = threadIdx.x & 63; if (wave >= M) return;
    const int b = wave / L; const float* r = in + (size_t)wave * in_ld; float s = 0.f;
    for (int k = lane; k < ncol; k += 64) s += r[k] * r[k];
    s = wsum(s); const float rs = rsqrtf(s / ncol + EPS);
    float* o = out + (size_t)wave * out_ld + out_off;
    for (int k = lane; k < ncol; k += 64) { float v = r[k] * rs * g[k]; if (sc) v = v * (1.f + sc[b * 6 * D + k]) + sh[b * 6 * D + k]; o[k] = v; }
}
template <class TA> __device__ __forceinline__ float ldA(const TA* p) { return (float)*p; }
template <> __device__ __forceinline__ float ldA<__hip_bfloat16>(const __hip_bfloat16* p) { return __bfloat162float(*p); }
template <class TA, class Epi> __global__ void __launch_bounds__(256) k_gemm(const TA* A, const float* Bw, int Mm, int N, int K, Epi E) {
    __shared__ float As[16][65], Bs[16][65];
    const int tx = threadIdx.x & 15, ty = threadIdx.x >> 4, m0 = blockIdx.y * 64, n0 = blockIdx.x * 64;
    float acc[4][4];
#pragma unroll
    for (int i = 0; i < 4; ++i)
#pragma unroll
        for (int j = 0; j < 4; ++j) acc[i][j] = 0.f;
    for (int k0 = 0; k0 < K; k0 += 16) {
#pragma unroll
        for (int i = 0; i < 4; ++i) { const int e = threadIdx.x + 256 * i; const int r = e >> 4, kk = e & 15; As[kk][r] = ldA<TA>(A + (size_t)(m0 + r) * K + k0 + kk); }
#pragma unroll
        for (int i = 0; i < 4; ++i) { const int e = threadIdx.x + 256 * i; const int kk = e >> 6, cn = e & 63; Bs[kk][cn] = Bw[(size_t)(k0 + kk) * N + n0 + cn]; }
        __syncthreads();
#pragma unroll
        for (int kk = 0; kk < 16; ++kk) {
            float a[4], bb[4];
#pragma unroll
            for (int i = 0; i < 4; ++i) { a[i] = As[kk][ty * 4 + i]; bb[i] = Bs[kk][tx * 4 + i]; }
#pragma unroll
            for (int i = 0; i < 4; ++i)
#pragma unroll
                for (int j = 0; j < 4; ++j) acc[i][j] += a[i] * bb[j];
        }
        __syncthreads();
    }
#pragma unroll
    for (int i = 0; i < 4; ++i)
#pragma unroll
        for (int j = 0; j < 4; ++j) E(m0 + ty * 4 + i, n0 + tx * 4 + j, acc[i][j]);
}
struct EpiProj { float *q, *k, *v, *u; __device__ void operator()(int m, int n, float a) const { float* d = n < 512 ? q : n < 1024 ? k : n < 1536 ? v : u; d[(size_t)m * 512 + (n & 511)] = a; } };
struct EpiGlu { const float* y; const float* bg; float* s; __device__ void operator()(int m, int n, float a) const { const float yy = y[(size_t)m * 512 + n]; s[(size_t)m * 512 + n] = yy * sigmoidf_(a + bg[n]); } };
struct EpiRes { const float* base; const float* gate; float* out; __device__ void operator()(int m, int n, float a) const { const int b = m / L; out[(size_t)m * D + n] = base[(size_t)m * D + n] + gate[b * 6 * D + n] * a; } };
struct EpiFc1 { __hip_bfloat16* f; __device__ void operator()(int m, int n, float a) const { const float r = a > 0.f ? a : 0.f; f[(size_t)m * FF + n] = __float2bfloat16(r * r); } };

__global__ void k_rope(float* q, float* k) {
    const int idx = blockIdx.x * blockDim.x + threadIdx.x; if (idx >= M * H * 32) return;
    const int d = idx & 31, h = (idx >> 5) & 7, m = idx >> 8, t = m % L;
    const float inv = powf(10000.f, -(float)d / 32.f); const float ang = (float)t * inv; const float cs = cosf(ang), sn = sinf(ang);
    float* p = q + (size_t)m * 512 + h * 64 + d; float x1 = p[0], x2 = p[32]; p[0] = x1 * cs - x2 * sn; p[32] = x1 * sn + x2 * cs;
    p = k + (size_t)m * 512 + h * 64 + d; x1 = p[0]; x2 = p[32]; p[0] = x1 * cs - x2 * sn; p[32] = x1 * sn + x2 * cs;
}
__global__ void k_kmean(const float* k, float* km) {
    const int idx = blockIdx.x * blockDim.x + threadIdx.x; if (idx >= B * H * NB * HD) return;
    const int d = idx & 63, nb = (idx >> 6) & 31, h = (idx >> 11) & 7, b = idx >> 14; float s = 0.f;
    for (int t = 0; t < BLK; ++t) s += k[(size_t)(b * L + nb * BLK + t) * 512 + h * 64 + d];
    km[idx] = s / 256.f;
}
__global__ void __launch_bounds__(256) k_attn(float* q, const float* k, const float* v, const float* km) {
    const int wave = (blockIdx.x * blockDim.x + threadIdx.x) >> 6, lane = threadIdx.x & 63; if (wave >= M * H) return;
    const int h = wave & 7, m = wave >> 3, b = m / L, t = m % L, qi = t / BLK;
    const float qd = q[(size_t)m * 512 + h * 64 + lane];
    float gate = -INFINITY;
    { const int n = lane & 31; const float* kmp = km + ((size_t)(b * H + h) * NB + n) * HD; float s = 0.f;
      for (int d = 0; d < 64; ++d) s += __shfl(qd, d) * kmp[d];
      if (n < qi && lane < 32) gate = s; }
    int sel[3];
#pragma unroll
    for (int r = 0; r < 3; ++r) { float best = -INFINITY; int bi = -1;
        for (int n = 0; n < 32; ++n) { const float gn = __shfl(gate, n); if (gn > best) { best = gn; bi = n; } }
        sel[r] = bi; if (lane == bi) gate = -INFINITY; }
    float sc[16];
#pragma unroll
    for (int s = 0; s < 4; ++s) { const int blk = s < 3 ? sel[s] : qi; const bool valid = blk >= 0;
#pragma unroll
        for (int j = 0; j < 4; ++j) { float dot = -INFINITY;
            if (valid) { const int key = blk * BLK + j * 64 + lane; const float* kp = k + (size_t)(b * L + key) * 512 + h * 64; float a = 0.f;
                for (int d = 0; d < 64; ++d) a += __shfl(qd, d) * kp[d];
                dot = a * 0.125f; if (s == 3 && key > t) dot = -INFINITY; }
            sc[s * 4 + j] = dot; } }
    float mx = -INFINITY;
#pragma unroll
    for (int i = 0; i < 16; ++i) mx = fmaxf(mx, sc[i]);
    mx = wmax(mx); float sum = 0.f;
#pragma unroll
    for (int i = 0; i < 16; ++i) { sc[i] = expf(sc[i] - mx); sum += sc[i]; }
    sum = wsum(sum); float o = 0.f;
#pragma unroll
    for (int s = 0; s < 4; ++s) { const int blk = s < 3 ? sel[s] : qi; if (blk < 0) continue;
#pragma unroll
        for (int j = 0; j < 4; ++j) { const float* vp = v + (size_t)(b * L + blk * BLK + j * 64) * 512 + h * 64 + lane;
            for (int ll = 0; ll < 64; ++ll) o += __shfl(sc[s * 4 + j], ll) * vp[(size_t)ll * 512]; } }
    q[(size_t)m * 512 + h * 64 + lane] = o / sum;
}
__global__ void __launch_bounds__(64) k_ssm(float* u, const float* lam_re, const float* lam_im, const float* log_dt, const float* b_re, const float* b_im,
                                            const float* c_re, const float* c_im, const float* d_skip) {
    const int g = blockIdx.x & 31, b = blockIdx.x >> 5, p = threadIdx.x;
    const double lr = lam_re[g * P + p], li = lam_im[g * P + p], dt = exp((double)log_dt[g]);
    const double er = exp(lr * dt), ar = er * cos(li * dt), ai = er * sin(li * dt);
    const double nr = ar - 1.0, ni = ai, den = lr * lr + li * li; const double fr = (nr * lr + ni * li) / den, fi = (ni * lr - nr * li) / den;
    float Br[16], Bi[16], Cr[16], Ci[16];
#pragma unroll
    for (int n = 0; n < 16; ++n) { const double br = b_re[(g * P + p) * GC + n], bi = b_im[(g * P + p) * GC + n];
        Br[n] = (float)(fr * br - fi * bi); Bi[n] = (float)(fr * bi + fi * br);
        Cr[n] = c_re[(g * GC + n) * P + p]; Ci[n] = c_im[(g * GC + n) * P + p]; }
    const float a_r = (float)ar, a_i = (float)ai; float xr = 0.f, xi = 0.f;
    const float dsk = p < 16 ? d_skip[g * GC + p] : 0.f;
    for (int t = 0; t < L; ++t) { float* up = u + (size_t)(b * L + t) * 512 + g * GC; float bur = 0.f, bui = 0.f;
        const float myu = p < 16 ? up[p] : 0.f;
#pragma unroll
        for (int n = 0; n < 16; ++n) { const float un = __shfl(myu, n); bur += Br[n] * un; bui += Bi[n] * un; }
        const float nxr = a_r * xr - a_i * xi + bur, nxi = a_r * xi + a_i * xr + bui; xr = nxr; xi = nxi;
        float yv = 0.f;
#pragma unroll
        for (int n = 0; n < 16; ++n) { const float s = wsum(Cr[n] * xr - Ci[n] * xi); if (p == n) yv = s; }
        if (p < 16) up[p] = gelu_tanh(yv + dsk * myu); }
}
}

extern "C" void kernel_launch(void* const* d_in, const int* in_sizes, int n_in, void* d_out, int out_size, void* d_ws, size_t ws_size, hipStream_t stream) {
    using namespace nv;
    const float* x = (const float*)d_in[0]; const float* c = (const float*)d_in[1]; const float* w_ada = (const float*)d_in[2]; const float* b_ada = (const float*)d_in[3];
    const float* g_mix = (const float*)d_in[4]; const float* w_in = (const float*)d_in[5]; const float* g_attn = (const float*)d_in[6];
    const float* lam_re = (const float*)d_in[7]; const float* lam_im = (const float*)d_in[8]; const float* log_dt = (const float*)d_in[9];
    const float* b_re = (const float*)d_in[10]; const float* b_im = (const float*)d_in[11]; const float* c_re = (const float*)d_in[12]; const float* c_im = (const float*)d_in[13];
    const float* d_skip = (const float*)d_in[14]; const float* w_glu = (const float*)d_in[15]; const float* b_glu = (const float*)d_in[16]; const float* g_ssm = (const float*)d_in[17];
    const float* w_out = (const float*)d_in[18]; const float* g_mlp = (const float*)d_in[19]; const float* w_fc1 = (const float*)d_in[20]; const float* w_fc2 = (const float*)d_in[21];
    const float* g_final = (const float*)d_in[22];
    float* out = (float*)d_out; char* ws = (char*)d_ws; const size_t MiB = 1u << 20;
    float* mod = (float*)(ws + 1 * MiB);
    float* km = (float*)(ws + 2 * MiB);
    float* hbuf = (float*)(ws + 8 * MiB);
    float* qb = (float*)(ws + 72 * MiB); float* kb = (float*)(ws + 104 * MiB); float* vb = (float*)(ws + 136 * MiB); float* ub = (float*)(ws + 168 * MiB);
    __hip_bfloat16* fb = (__hip_bfloat16*)(ws + 72 * MiB);
    const float *sh1 = mod, *sc1 = mod + D, *gt1 = mod + 2 * D, *sh2 = mod + 3 * D, *sc2 = mod + 4 * D, *gt2 = mod + 5 * D;
    k_mod<<<(6 * D + 255) / 256, 256, 0, stream>>>(c, w_ada, b_ada, mod);
    k_rmsmod<<<M / 4, 256, 0, stream>>>(x, g_mix, sc1, sh1, hbuf, D, D, D, 0);
    k_gemm<float, EpiProj><<<dim3(2048 / 64, M / 64), 256, 0, stream>>>(hbuf, w_in, M, 2048, D, EpiProj{qb, kb, vb, ub});
    k_rope<<<M * H * 32 / 256, 256, 0, stream>>>(qb, kb);
    k_kmean<<<B * H * NB * HD / 256, 256, 0, stream>>>(kb, km);
    k_attn<<<M * H / 4, 256, 0, stream>>>(qb, kb, vb, km);
    k_ssm<<<B * G, 64, 0, stream>>>(ub, lam_re, lam_im, log_dt, b_re, b_im, c_re, c_im, d_skip);
    k_gemm<float, EpiGlu><<<dim3(512 / 64, M / 64), 256, 0, stream>>>(ub, w_glu, M, 512, 512, EpiGlu{ub, b_glu, kb});
    k_rmsmod<<<M / 4, 256, 0, stream>>>(qb, g_attn, nullptr, nullptr, hbuf, 512, 512, D, 0);
    k_rmsmod<<<M / 4, 256, 0, stream>>>(kb, g_ssm, nullptr, nullptr, hbuf, 512, 512, D, 512);
    k_gemm<float, EpiRes><<<dim3(D / 64, M / 64), 256, 0, stream>>>(hbuf, w_out, M, D, D, EpiRes{x, gt1, out});
    k_rmsmod<<<M / 4, 256, 0, stream>>>(out, g_mlp, sc2, sh2, hbuf, D, D, D, 0);
    k_gemm<float, EpiFc1><<<dim3(FF / 64, M / 64), 256, 0, stream>>>(hbuf, w_fc1, M, FF, D, EpiFc1{fb});
    k_gemm<__hip_bfloat16, EpiRes><<<dim3(D / 64, M / 64), 256, 0, stream>>>(fb, w_fc2, M, D, FF, EpiRes{out, gt2, out});
    k_rmsmod<<<M / 4, 256, 0, stream>>>(out, g_final, nullptr, nullptr, out, D, D, D, 0);
}
```

```cpp
#include <hip/hip_runtime.h>
#include <hip/hip_bf16.h>
#include <cstdio>
#include <cstdint>

namespace pg8 {
#define PG8_LAS __attribute__((address_space(3)))
typedef unsigned short bf16_t;
typedef short bf16x8 __attribute__((ext_vector_type(8)));
typedef float f32x4 __attribute__((ext_vector_type(4)));
typedef unsigned u32x4 __attribute__((ext_vector_type(4)));
constexpr int BM = 256, BK = 64, HALF = 128, HTB = HALF * BK * 2  , STAGE_BYTES = 8 * HTB, NXCD = 8, WGM = 8;

__host__ __device__ __forceinline__ int lds_byte(int r, int c) { const int st = (r >> 4) * 2 + (c >> 5), rr = r & 15, cc = c & 31, ob = rr * 64 + cc * 2; return st * 1024 + (ob ^ (((ob >> 9) & 1) << 5)); }
__host__ __device__ __forceinline__ void stage_rc(int b, int& R, int& C) { const int st = b / 1024, sb = b % 1024, swz = sb ^ (((sb >> 9) & 1) << 5); R = (st >> 1) * 16 + swz / 64; C = (st & 1) * 32 + (swz % 64) / 2; }
__host__ __device__ __forceinline__ int perm32(int rho) { const int n = rho >> 4, i = rho & 15; return 8 * (i >> 2) + 4 * n + (i & 3); }

struct Unit { int pm, pn; };
struct Gemm { const bf16_t* A; const bf16_t* Bt; int M, N, K; size_t bbytes; int tmid; };

struct StaticOrder {
    int nM, nN, nwg, G, c;
    __host__ __device__ void init(int M, int N, int G_, int c_) { nM = M / BM; nN = N / BM; nwg = nM * nN; G = G_; c = c_; }
    __host__ __device__ bool next(int i, Unit& u) const {
        const long L = (long)i * G + c; if (L >= nwg) return false;
        int wgid = (int)L; { const int q = nwg / NXCD, r = nwg % NXCD, xcd = wgid % NXCD, off = wgid / NXCD; wgid = (xcd < r ? xcd * (q + 1) : r * (q + 1) + (xcd - r) * q) + off; }
        const int nig = WGM * nN, gid = wgid / nig, fm = gid * WGM, gsz = (nM - fm) < WGM ? (nM - fm) : WGM;
        u.pm = fm + ((wgid % nig) % gsz); u.pn = (wgid % nig) / gsz; return true;
    }
    __device__ __forceinline__ void a_ready(const Unit&) const {}
    __device__ __forceinline__ void done(const Unit&) const {}
};


__device__ __forceinline__ unsigned cvt_pk_bf16(float lo, float hi) { unsigned r; asm volatile("v_cvt_pk_bf16_f32 %0, %1, %2" : "=v"(r) : "v"(lo), "v"(hi)); return r; }

typedef unsigned u32x2 __attribute__((ext_vector_type(2)));
constexpr float RMS_EPS = 1e-6f;
__device__ __forceinline__ u32x2 pk4(const f32x4 v) { u32x2 w; w.x = cvt_pk_bf16(v[0], v[1]); w.y = cvt_pk_bf16(v[2], v[3]); return w; }
__device__ __forceinline__ u32x4 pk8(const f32x4 a, const f32x4 b) { u32x4 w; w.x = cvt_pk_bf16(a[0], a[1]); w.y = cvt_pk_bf16(a[2], a[3]); w.z = cvt_pk_bf16(b[0], b[1]); w.w = cvt_pk_bf16(b[2], b[3]); return w; }
__device__ __forceinline__ float bflo(unsigned w) { return __builtin_bit_cast(float, w << 16); }
__device__ __forceinline__ float bfhi(unsigned w) { return __builtin_bit_cast(float, w & 0xffff0000u); }

struct EpiProj {
    static constexpr bool PERM = true, AFTER_DRAIN = false, MID = false;
    const float* rstd; const float* bias; const float* rope; bf16_t* Q; bf16_t* Kk; bf16_t* V; bf16_t* U; float* ksum; float qscale;
    __device__ __forceinline__ void mid(f32x4 (&)[2][2][4][2], const Unit&, int, int) const {}
    __device__ __forceinline__ void operator()(const f32x4 (&acc)[2][2][4][2], const Unit& u, int wr, int wc, int fr, int fq) const {
        const int b = u.pm >> 5, sect = u.pn >> 1;
        const int lc = (u.pn & 1) * 256 + wc * 32 + 8 * fq;
        const float* bp = bias + b * 2048 + u.pn * 256 + wc * 32 + 8 * fq;
        f32x4 bv[2][2];
#pragma unroll
        for (int bj = 0; bj < 2; ++bj)
#pragma unroll
            for (int n = 0; n < 2; ++n) bv[bj][n] = *(const f32x4*)(bp + bj * 128 + 4 * n);
        const int row0 = u.pm * 256 + wr * 64 + fr;
        if (sect < 2) {
            bf16_t* Tn = sect == 0 ? Q : Kk; const float sc = sect == 0 ? qscale : 1.f;
            const int a = 4 * (wc & 1) + fq;
            f32x4 ks1[2], ks2[2];
#pragma unroll
            for (int bj = 0; bj < 2; ++bj) { ks1[bj] = (f32x4){0.f, 0.f, 0.f, 0.f}; ks2[bj] = (f32x4){0.f, 0.f, 0.f, 0.f}; }
#pragma unroll
            for (int ai = 0; ai < 2; ++ai)
#pragma unroll
                for (int m = 0; m < 4; ++m) {
                    const int r = row0 + ai * 128 + m * 16, t = r & 8191; const float rs = rstd[r];
                    const float* rp = rope + ((size_t)t * 8 + a) * 8; const f32x4 cs = *(const f32x4*)rp, sn = *(const f32x4*)(rp + 4);
#pragma unroll
                    for (int bj = 0; bj < 2; ++bj) {
                        const f32x4 x1 = acc[ai][bj][m][0] * rs + bv[bj][0], x2 = acc[ai][bj][m][1] * rs + bv[bj][1];
                        f32x4 o1 = x1 * cs - x2 * sn, o2 = x1 * sn + x2 * cs;
                        ks1[bj] += o1; ks2[bj] += o2;
                        o1 = o1 * sc; o2 = o2 * sc;
                        bf16_t* p = Tn + (size_t)r * 512 + ((lc + bj * 128) & ~63) + 4 * a;
                        *(u32x2*)p = pk4(o1); *(u32x2*)(p + 32) = pk4(o2);
                    }
                }
            if (sect == 1) {
#pragma unroll
                for (int bj = 0; bj < 2; ++bj)
#pragma unroll
                    for (int i = 0; i < 4; ++i) {
                        float s1 = ks1[bj][i], s2 = ks2[bj][i];
#pragma unroll
                        for (int o = 1; o < 16; o <<= 1) { s1 += __shfl_xor(s1, o); s2 += __shfl_xor(s2, o); }
                        if (fr == 0) { const int head = (lc + bj * 128) >> 6, blk = u.pm & 31; float* kp = ksum + ((size_t)((b * 8 + head) * 32 + blk)) * 64 + 4 * a + i;
                            atomicAdd(kp, s1); atomicAdd(kp + 32, s2); }
                    }
            }
        } else {
            bf16_t* Tn = sect == 2 ? V : U;
#pragma unroll
            for (int ai = 0; ai < 2; ++ai)
#pragma unroll
                for (int m = 0; m < 4; ++m) {
                    const int r = row0 + ai * 128 + m * 16; const float rs = rstd[r];
#pragma unroll
                    for (int bj = 0; bj < 2; ++bj) {
                        const f32x4 v0 = acc[ai][bj][m][0] * rs + bv[bj][0], v1 = acc[ai][bj][m][1] * rs + bv[bj][1];
                        *(u32x4*)(Tn + (size_t)r * 512 + lc + bj * 128) = pk8(v0, v1);
                    }
                }
        }
    }
};
struct EpiGlu {
    static constexpr bool PERM = true, AFTER_DRAIN = false, MID = false;
    const bf16_t* Y; const float* bg; bf16_t* MIX; float* ssq;
    __device__ __forceinline__ void mid(f32x4 (&)[2][2][4][2], const Unit&, int, int) const {}
    __device__ __forceinline__ void operator()(const f32x4 (&acc)[2][2][4][2], const Unit& u, int wr, int wc, int fr, int fq) const {
        const int c0 = u.pn * 256 + wc * 32 + 8 * fq, row0 = u.pm * 256 + wr * 64 + fr;
        f32x4 bv[2][2];
#pragma unroll
        for (int bj = 0; bj < 2; ++bj)
#pragma unroll
            for (int n = 0; n < 2; ++n) bv[bj][n] = *(const f32x4*)(bg + c0 + bj * 128 + 4 * n);
#pragma unroll
        for (int ai = 0; ai < 2; ++ai)
#pragma unroll
            for (int m = 0; m < 4; ++m) {
                const int r = row0 + ai * 128 + m * 16; float sq = 0.f;
#pragma unroll
                for (int bj = 0; bj < 2; ++bj) {
                    const u32x4 yw = *(const u32x4*)(Y + (size_t)r * 512 + c0 + bj * 128);
                    const f32x4 y0 = (f32x4){bflo(yw.x), bfhi(yw.x), bflo(yw.y), bfhi(yw.y)}, y1 = (f32x4){bflo(yw.z), bfhi(yw.z), bflo(yw.w), bfhi(yw.w)};
                    const f32x4 z0 = acc[ai][bj][m][0] + bv[bj][0], z1 = acc[ai][bj][m][1] + bv[bj][1];
                    f32x4 s0, s1;
#pragma unroll
                    for (int i = 0; i < 4; ++i) { s0[i] = y0[i] / (1.f + __expf(-z0[i])); s1[i] = y1[i] / (1.f + __expf(-z1[i])); sq += s0[i] * s0[i] + s1[i] * s1[i]; }
                    *(u32x4*)(MIX + (size_t)r * 1024 + c0 + bj * 128) = pk8(s0, s1);
                }
                sq += __shfl_xor(sq, 16); sq += __shfl_xor(sq, 32);
                if (fq == 0) atomicAdd(ssq + r, sq);
            }
    }
};
struct EpiOut {
    static constexpr bool PERM = true, AFTER_DRAIN = false, MID = true;
    const float* x; const float* gate; float* X1; bf16_t* XB2; float* ssq1; const float* ssqs;
    __device__ __forceinline__ void mid(f32x4 (&acc)[2][2][4][2], const Unit& u, int wr, int fr) const {
#pragma unroll
        for (int ai = 0; ai < 2; ++ai)
#pragma unroll
            for (int m = 0; m < 4; ++m) { const int r = u.pm * 256 + wr * 64 + fr + ai * 128 + m * 16; const float sv = 1.0f / sqrtf(ssqs[r] * (1.0f / 512.0f) + RMS_EPS);
#pragma unroll
                for (int bj = 0; bj < 2; ++bj)
#pragma unroll
                    for (int n = 0; n < 2; ++n) acc[ai][bj][m][n] = acc[ai][bj][m][n] * sv; }
    }
    __device__ __forceinline__ void operator()(const f32x4 (&acc)[2][2][4][2], const Unit& u, int wr, int wc, int fr, int fq) const {
        const int b = u.pm >> 5, c0 = u.pn * 256 + wc * 32 + 8 * fq, row0 = u.pm * 256 + wr * 64 + fr;
        f32x4 gv[2][2];
#pragma unroll
        for (int bj = 0; bj < 2; ++bj)
#pragma unroll
            for (int n = 0; n < 2; ++n) gv[bj][n] = *(const f32x4*)(gate + b * 6144 + c0 + bj * 128 + 4 * n);
#pragma unroll
        for (int ai = 0; ai < 2; ++ai)
#pragma unroll
            for (int m = 0; m < 4; ++m) {
                const int r = row0 + ai * 128 + m * 16; float sq = 0.f;
#pragma unroll
                for (int bj = 0; bj < 2; ++bj) {
                    const size_t off = (size_t)r * 1024 + c0 + bj * 128;
                    const f32x4 o0 = *(const f32x4*)(x + off) + gv[bj][0] * acc[ai][bj][m][0], o1 = *(const f32x4*)(x + off + 4) + gv[bj][1] * acc[ai][bj][m][1];
                    *(f32x4*)(X1 + off) = o0; *(f32x4*)(X1 + off + 4) = o1;
                    *(u32x4*)(XB2 + off) = pk8(o0, o1);
#pragma unroll
                    for (int i = 0; i < 4; ++i) sq += o0[i] * o0[i] + o1[i] * o1[i];
                }
                sq += __shfl_xor(sq, 16); sq += __shfl_xor(sq, 32);
                if (fq == 0) atomicAdd(ssq1 + r, sq);
            }
    }
};
struct EpiFc1 {
    static constexpr bool PERM = true, AFTER_DRAIN = false, MID = false;
    const float* ssq1; const float* bias2; bf16_t* Hh;
    __device__ __forceinline__ void mid(f32x4 (&)[2][2][4][2], const Unit&, int, int) const {}
    __device__ __forceinline__ void operator()(const f32x4 (&acc)[2][2][4][2], const Unit& u, int wr, int wc, int fr, int fq) const {
        const int b = u.pm >> 5, c0 = u.pn * 256 + wc * 32 + 8 * fq, row0 = u.pm * 256 + wr * 64 + fr;
        f32x4 bv[2][2];
#pragma unroll
        for (int bj = 0; bj < 2; ++bj)
#pragma unroll
            for (int n = 0; n < 2; ++n) bv[bj][n] = *(const f32x4*)(bias2 + b * 4096 + c0 + bj * 128 + 4 * n);
#pragma unroll
        for (int ai = 0; ai < 2; ++ai)
#pragma unroll
            for (int m = 0; m < 4; ++m) {
                const int r = row0 + ai * 128 + m * 16; const float rs = 1.0f / sqrtf(ssq1[r] * (1.0f / 1024.0f) + RMS_EPS);
#pragma unroll
                for (int bj = 0; bj < 2; ++bj) {
                    f32x4 v0 = acc[ai][bj][m][0] * rs + bv[bj][0], v1 = acc[ai][bj][m][1] * rs + bv[bj][1];
#pragma unroll
                    for (int i = 0; i < 4; ++i) { const float a0 = fmaxf(v0[i], 0.f), a1 = fmaxf(v1[i], 0.f); v0[i] = a0 * a0; v1[i] = a1 * a1; }
                    *(u32x4*)(Hh + (size_t)r * 4096 + c0 + bj * 128) = pk8(v0, v1);
                }
            }
    }
};
struct EpiFc2 {
    static constexpr bool PERM = true, AFTER_DRAIN = false, MID = false;
    const float* gate; float* OUT; float* ssq2;
    __device__ __forceinline__ void mid(f32x4 (&)[2][2][4][2], const Unit&, int, int) const {}
    __device__ __forceinline__ void operator()(const f32x4 (&acc)[2][2][4][2], const Unit& u, int wr, int wc, int fr, int fq) const {
        const int b = u.pm >> 5, c0 = u.pn * 256 + wc * 32 + 8 * fq, row0 = u.pm * 256 + wr * 64 + fr;
        f32x4 gv[2][2];
#pragma unroll
        for (int bj = 0; bj < 2; ++bj)
#pragma unroll
            for (int n = 0; n < 2; ++n) gv[bj][n] = *(const f32x4*)(gate + b * 6144 + c0 + bj * 128 + 4 * n);
#pragma unroll
        for (int ai = 0; ai < 2; ++ai)
#pragma unroll
            for (int m = 0; m < 4; ++m) {
                const int r = row0 + ai * 128 + m * 16; float sq = 0.f;
#pragma unroll
                for (int bj = 0; bj < 2; ++bj) {
                    const size_t off = (size_t)r * 1024 + c0 + bj * 128;
                    const f32x4 o0 = *(const f32x4*)(OUT + off) + gv[bj][0] * acc[ai][bj][m][0], o1 = *(const f32x4*)(OUT + off + 4) + gv[bj][1] * acc[ai][bj][m][1];
                    *(f32x4*)(OUT + off) = o0; *(f32x4*)(OUT + off + 4) = o1;
#pragma unroll
                    for (int i = 0; i < 4; ++i) sq += o0[i] * o0[i] + o1[i] * o1[i];
                }
                sq += __shfl_xor(sq, 16); sq += __shfl_xor(sq, 32);
                if (fq == 0) atomicAdd(ssq2 + r, sq);
            }
    }
};

template <class Epi, class Sched, bool ALIGN_EPI = false, bool SP2 = false>
__device__ __forceinline__ void gemm_phase(PG8_LAS unsigned char* lds, const Gemm g, const Sched& S, const Epi& E) {
    const int tid = threadIdx.x, wid = __builtin_amdgcn_readfirstlane(tid >> 6), lane = tid & 63, wr = wid >> 2, wc = wid & 3, fr = lane & 15, fq = lane >> 4;
    const int K = g.K, nt = K / BK;
    unsigned voffA[2], voffB[2];
#pragma unroll
    for (int i = 0; i < 2; ++i) { int R, C; stage_rc(tid * 16 + i * 8192, R, C); const int Rb = Epi::PERM ? ((R & ~31) + perm32(R & 31)) : R;
        voffA[i] = (unsigned)(R * K + C) * 2u; voffB[i] = (unsigned)(Rb * K + C) * 2u; }
    const size_t kstep = (size_t)(BK * 2);
    const size_t hstep = (size_t)HALF * K * 2;
    const size_t tstep = 2 * hstep;
    const unsigned ldsw = (unsigned)wid * 1024u;
    const int aoff = lds_byte(wr * 64 + fr, fq * 8), boff = lds_byte(wc * 32 + fr, fq * 8);
#define PG8_SA(b, h) (((b) * 2 + (h)) * HTB)
#define PG8_SB(b, h) ((4 + (b) * 2 + (h)) * HTB)
#define PG8_STAGE(bufoff, gbase, voff) do { _Pragma("unroll") for (int _i = 0; _i < 2; ++_i) \
        __builtin_amdgcn_global_load_lds((const unsigned*)((const char*)(gbase) + (voff)[_i]), (PG8_LAS unsigned*)(lds + (bufoff) + ldsw + _i * 8192), 16, 0, 0); } while (0)
#define PG8_LDA(dst, b, h) do { _Pragma("unroll") for (int m = 0; m < 4; ++m) _Pragma("unroll") for (int k = 0; k < 2; ++k) dst[m][k] = *(const PG8_LAS bf16x8*)(lds + PG8_SA(b, h) + aoff + m * 2048 + k * 1024); } while (0)
#define PG8_LDB(dst, b, h) do { _Pragma("unroll") for (int n = 0; n < 2; ++n) _Pragma("unroll") for (int k = 0; k < 2; ++k) dst[n][k] = *(const PG8_LAS bf16x8*)(lds + PG8_SB(b, h) + boff + n * 2048 + k * 1024); } while (0)
#define PG8_MMA(ai, bj, At, Bt) do { __builtin_amdgcn_s_setprio(1); _Pragma("unroll") for (int m = 0; m < 4; ++m) _Pragma("unroll") for (int n = 0; n < 2; ++n) _Pragma("unroll") for (int k = 0; k < 2; ++k) \
        acc[ai][bj][m][n] = __builtin_amdgcn_mfma_f32_16x16x32_bf16(Bt[n][k], At[m][k], acc[ai][bj][m][n], 0, 0, 0); __builtin_amdgcn_s_setprio(0); } while (0)
#define PG8_WAIT_V(n) asm volatile("s_waitcnt vmcnt(" #n ")" ::: "memory")
#define PG8_WAIT_L(n) asm volatile("s_waitcnt lgkmcnt(" #n ")" ::: "memory")
#define PG8_BAR __builtin_amdgcn_s_barrier()
#define PG8_SCHED __builtin_amdgcn_sched_barrier(0)
    Unit cur, nxt; int ui = 0;
    if (!S.next(0, cur)) return;
    f32x4 acc[2][2][4][2];
#pragma unroll
    for (int a = 0; a < 2; ++a)
#pragma unroll
        for (int b = 0; b < 2; ++b)
#pragma unroll
            for (int m = 0; m < 4; ++m)
#pragma unroll
                for (int n = 0; n < 2; ++n) acc[a][b][m][n] = (f32x4){0.f, 0.f, 0.f, 0.f};
    bf16x8 At[4][2], B0[2][2], B1[2][2];
    const char* cA = (const char*)g.A + (size_t)cur.pm * tstep; const char* cB = (const char*)g.Bt + (size_t)(cur.pm >> 5) * g.bbytes + (size_t)cur.pn * tstep;
    S.a_ready(cur);
    if constexpr (SP2) {
        PG8_STAGE(PG8_SB(0, 0), cB, voffB); PG8_STAGE(PG8_SB(0, 1), cB + hstep, voffB); PG8_STAGE(PG8_SA(0, 0), cA, voffA); PG8_STAGE(PG8_SA(0, 1), cA + hstep, voffA);
        if (wr == 1) PG8_BAR;
        PG8_WAIT_V(2); PG8_BAR;
        PG8_STAGE(PG8_SB(1, 0), cB + kstep, voffB); PG8_STAGE(PG8_SA(1, 0), cA + kstep, voffA); PG8_STAGE(PG8_SB(1, 1), cB + hstep + kstep, voffB);
        PG8_WAIT_V(6); PG8_BAR;
    } else {
        PG8_STAGE(PG8_SB(0, 0), cB, voffB); PG8_STAGE(PG8_SA(0, 0), cA, voffA); PG8_STAGE(PG8_SB(0, 1), cB + hstep, voffB); PG8_STAGE(PG8_SA(0, 1), cA + hstep, voffA);
        if (wr == 1) PG8_BAR;
        PG8_WAIT_V(4); PG8_BAR;
        PG8_STAGE(PG8_SB(1, 0), cB + kstep, voffB); PG8_STAGE(PG8_SA(1, 0), cA + kstep, voffA); PG8_STAGE(PG8_SB(1, 1), cB + hstep + kstep, voffB);
        PG8_WAIT_V(6); PG8_BAR;
    }
    for (;;) {
        const bool has_next = S.next(ui + 1, nxt);
        const char* nA = has_next ? (const char*)g.A + (size_t)nxt.pm * tstep : cA; const char* nB = has_next ? (const char*)g.Bt + (size_t)(nxt.pm >> 5) * g.bbytes + (size_t)nxt.pn * tstep : cB;
        for (int t = 0; t < nt; t += 2) {
            const bool last = (t == nt - 2);
            if constexpr (Epi::MID) { if (t == g.tmid) E.mid(acc, cur, wr, fr); }
            const char* a1 = cA + (size_t)(t + 1) * kstep;
            const char* a2 = last ? nA : cA + (size_t)(t + 2) * kstep; const char* b2 = last ? nB : cB + (size_t)(t + 2) * kstep;
            const char* a3 = a2 + kstep; const char* b3 = b2 + kstep;
            if (last && has_next) S.a_ready(nxt);
            if constexpr (SP2) {
            PG8_LDB(B0, 0, 0); PG8_LDB(B1, 0, 1); PG8_SCHED; PG8_LDA(At, 0, 0); PG8_STAGE(PG8_SA(1, 1), a1 + hstep, voffA);
            PG8_WAIT_V(8); PG8_WAIT_L(0); PG8_BAR; PG8_MMA(0, 0, At, B0); PG8_MMA(0, 1, At, B1); PG8_BAR; PG8_SCHED;
            PG8_LDA(At, 0, 1); PG8_STAGE(PG8_SB(0, 0), b2, voffB); PG8_STAGE(PG8_SB(0, 1), b2 + hstep, voffB); PG8_STAGE(PG8_SA(0, 0), a2, voffA);
            PG8_WAIT_V(8); PG8_WAIT_L(0); PG8_BAR; PG8_MMA(1, 0, At, B0); PG8_MMA(1, 1, At, B1); PG8_BAR; PG8_SCHED;
            PG8_LDB(B0, 1, 0); PG8_LDB(B1, 1, 1); PG8_SCHED; PG8_LDA(At, 1, 0); PG8_STAGE(PG8_SA(0, 1), a2 + hstep, voffA);
            PG8_WAIT_V(8); PG8_WAIT_L(0); PG8_BAR; PG8_MMA(0, 0, At, B0); PG8_MMA(0, 1, At, B1); PG8_BAR; PG8_SCHED;
            PG8_LDA(At, 1, 1); PG8_STAGE(PG8_SB(1, 0), b3, voffB); PG8_STAGE(PG8_SB(1, 1), b3 + hstep, voffB); PG8_STAGE(PG8_SA(1, 0), a3, voffA);
            PG8_WAIT_V(8); PG8_WAIT_L(0); PG8_BAR; PG8_MMA(1, 0, At, B0); PG8_MMA(1, 1, At, B1); PG8_BAR; PG8_SCHED;
            } else {
            PG8_LDB(B0, 0, 0); PG8_SCHED; PG8_LDA(At, 0, 0); PG8_STAGE(PG8_SA(1, 1), a1 + hstep, voffA);
            PG8_WAIT_L(8); PG8_BAR; PG8_WAIT_L(0); PG8_MMA(0, 0, At, B0); PG8_BAR; PG8_SCHED;
            PG8_LDB(B1, 0, 1); PG8_STAGE(PG8_SB(0, 0), b2, voffB);
            PG8_BAR; PG8_WAIT_L(0); PG8_MMA(0, 1, At, B1); PG8_BAR;
            PG8_LDA(At, 0, 1); PG8_STAGE(PG8_SA(0, 0), a2, voffA);
            PG8_BAR; PG8_WAIT_L(0); PG8_MMA(1, 0, At, B0); PG8_BAR; PG8_SCHED;
            PG8_STAGE(PG8_SB(0, 1), b2 + hstep, voffB);
            PG8_WAIT_V(6); PG8_BAR; PG8_MMA(1, 1, At, B1); PG8_BAR;
            PG8_LDB(B0, 1, 0); PG8_SCHED; PG8_LDA(At, 1, 0); PG8_STAGE(PG8_SA(0, 1), a2 + hstep, voffA);
            PG8_WAIT_L(8); PG8_BAR; PG8_WAIT_L(0); PG8_MMA(0, 0, At, B0); PG8_BAR; PG8_SCHED;
            PG8_LDB(B1, 1, 1); PG8_STAGE(PG8_SB(1, 0), b3, voffB);
            PG8_BAR; PG8_WAIT_L(0); PG8_MMA(0, 1, At, B1); PG8_BAR;
            PG8_LDA(At, 1, 1); PG8_STAGE(PG8_SA(1, 0), a3, voffA);
            PG8_BAR; PG8_WAIT_L(0); PG8_MMA(1, 0, At, B0); PG8_BAR; PG8_SCHED;
            PG8_STAGE(PG8_SB(1, 1), b3 + hstep, voffB);
            PG8_WAIT_V(6); PG8_BAR; PG8_MMA(1, 1, At, B1); PG8_BAR;
            }
        }
        if constexpr (ALIGN_EPI) { if (wr == 0) PG8_BAR; }
        if constexpr (!Epi::AFTER_DRAIN) { E(acc, cur, wr, wc, fr, fq); S.done(cur); }
        if (!has_next) break;
#pragma unroll
        for (int a = 0; a < 2; ++a)
#pragma unroll
            for (int b = 0; b < 2; ++b)
#pragma unroll
                for (int m = 0; m < 4; ++m)
#pragma unroll
                    for (int n = 0; n < 2; ++n) acc[a][b][m][n] = (f32x4){0.f, 0.f, 0.f, 0.f};
        cur = nxt; cA = nA; cB = nB; ++ui;
        if constexpr (ALIGN_EPI) { if (wr == 1) PG8_BAR; }
    }
    PG8_WAIT_V(0);
    if constexpr (!ALIGN_EPI) { if (wr == 0) PG8_BAR; }
    PG8_BAR;
    if constexpr (Epi::AFTER_DRAIN) { E.fused(acc, cur, wr, wc, fr, fq, lds, wid, lane); S.done(cur); }
#undef PG8_SA
#undef PG8_SB
#undef PG8_STAGE
#undef PG8_LDA
#undef PG8_LDB
#undef PG8_MMA
#undef PG8_WAIT_V
#undef PG8_WAIT_L
#undef PG8_BAR
#undef PG8_SCHED
}
}


#define GAS __attribute__((address_space(1)))
#define LAS __attribute__((address_space(3)))
typedef unsigned short bf16;
typedef unsigned v4u __attribute__((ext_vector_type(4)));
typedef float f32x4 __attribute__((ext_vector_type(4)));
typedef short bf16x8 __attribute__((ext_vector_type(8)));
typedef GAS unsigned gu32;
typedef GAS unsigned long long gu64;
#define RLX_AGENT __ATOMIC_RELAXED, __HIP_MEMORY_SCOPE_AGENT
#define LDS_WAIT() asm volatile("s_waitcnt lgkmcnt(0)" ::: "memory")
#define VM_WAIT() asm volatile("s_waitcnt vmcnt(0)" ::: "memory")
__device__ __forceinline__ unsigned long long rt() { return __builtin_amdgcn_s_memrealtime(); }
__device__ __forceinline__ unsigned f2bf(float f) { unsigned u = __builtin_bit_cast(unsigned, f); return (u + 0x7fffu + ((u >> 16) & 1u)) >> 16; }
__device__ __forceinline__ unsigned pk2(float lo, float hi) { return f2bf(lo) | (f2bf(hi) << 16); }


#define XB_TMO      128
#define XB_XCNT(j)  (256  + 64 * (j))
#define XB_XSUB(j)  (1280 + 64 * (j))
#define XB_XGEN(j)  (2304 + 64 * (j))
#define XB_TOP      3328
#define XB_TOPGEN   3392
#define XCD_BAR_WORDS 3456
#define XB_SPIN_CAP (1u << 18)

__device__ __forceinline__ unsigned xb_ld(unsigned* p)              { return __hip_atomic_load(p, __ATOMIC_RELAXED, __HIP_MEMORY_SCOPE_AGENT); }
__device__ __forceinline__ unsigned xb_add(unsigned* p, unsigned v) { return __hip_atomic_fetch_add(p, v, __ATOMIC_RELAXED, __HIP_MEMORY_SCOPE_AGENT); }
__device__ __forceinline__ unsigned xb_xcc_id() { return (unsigned)__builtin_amdgcn_s_getreg((3 << 11) | 20) & 0xFu; }
#define XB_SPIN(cond, bar) do { unsigned _sp = 0; while (cond) { __builtin_amdgcn_s_sleep(1); \
    if ((++_sp & 255u) == 0u) { if (xb_ld(&(bar)[XB_TMO])) break; if (_sp > XB_SPIN_CAP) { atomicAdd(&(bar)[XB_TMO], 1u); break; } } } } while (0)

struct XcdBarrier {
    unsigned* bar; unsigned x;
    volatile LAS unsigned* st;
};

__device__ __forceinline__ XcdBarrier xcd_barrier_post(unsigned* bar, volatile LAS unsigned* st) {
    XcdBarrier b; b.bar = bar; b.x = xb_xcc_id(); b.st = st;
    if (threadIdx.x == 0) (void)xb_add(&bar[XB_XCNT(b.x)], 1u);
    return b;
}
__device__ __forceinline__ void xcd_barrier_complete(unsigned* bar, unsigned x, unsigned& nloc, unsigned& nx) {
    const unsigned G = gridDim.x * gridDim.y * gridDim.z;
    unsigned sum, cnt, mine, sp = 0u;
    for (;;) {
        sum = 0u; cnt = 0u; mine = 0u;
#pragma unroll
        for (unsigned j = 0; j < 16; ++j) { const unsigned c = xb_ld(&bar[XB_XCNT(j)]); sum += c; cnt += (c > 0u) ? 1u : 0u; mine = (j == x) ? c : mine; }
        if (sum == G) break;
        __builtin_amdgcn_s_sleep(1);
        if ((++sp & 255u) == 0u) { if (xb_ld(&bar[XB_TMO])) break; if (sp > XB_SPIN_CAP) { atomicAdd(&bar[XB_TMO], 1u); break; } }
    }
    nloc = mine > 0u ? mine : 1u; nx = cnt > 0u ? cnt : 1u;
}

__device__ __forceinline__ void xcd_barrier(const XcdBarrier& b) {
    asm volatile("s_waitcnt vmcnt(0)" ::: "memory");
    __syncthreads();
    if (threadIdx.x == 0) {
        unsigned* bar = b.bar;
        __builtin_amdgcn_s_waitcnt(0);
        unsigned nloc = b.st[0], nx = b.st[1];
        if (nloc == 0u) { xcd_barrier_complete(bar, b.x, nloc, nx); b.st[0] = nloc; b.st[1] = nx; }
        const unsigned old = xb_add(&bar[XB_XSUB(b.x)], 1u);
        const unsigned gen = old / nloc;
        if (old + 1u == (gen + 1u) * nloc) {
            __builtin_amdgcn_fence(__ATOMIC_RELEASE, "agent");
            asm volatile("s_waitcnt vmcnt(0)" ::: "memory");
            const unsigned og = xb_add(&bar[XB_TOP], 1u);
            const unsigned tg = og / nx;
            if (og + 1u == (tg + 1u) * nx) xb_add(&bar[XB_TOPGEN], 1u);
            else XB_SPIN(xb_ld(&bar[XB_TOPGEN]) == tg, bar);
            __builtin_amdgcn_fence(__ATOMIC_ACQUIRE, "agent");
            xb_add(&bar[XB_XGEN(b.x)], 1u);
            asm volatile("s_waitcnt vmcnt(0)" ::: "memory");
        } else {
            XB_SPIN(xb_ld(&bar[XB_XGEN(b.x)]) == gen, bar);
            __builtin_amdgcn_fence(__ATOMIC_ACQUIRE, "agent");
            asm volatile("s_waitcnt vmcnt(0)" ::: "memory");
        }
    }
    __syncthreads();
}


constexpr int NWAVES = 8;
constexpr int BATCH = 2, T = 8192, D = 1024, M = BATCH * T, FF = 4096, NPROJ = 2048;
constexpr float EPS = 1e-6f;
constexpr float C2 = 0.125f * 1.4426950408889634f;
constexpr int N_PHASES = 10;

constexpr size_t KiB = 1024, MiB = 1u << 20;
constexpr size_t WS_CTL = 0, CTL_ZERO_BYTES = 1 * MiB;
constexpr int CW_TMO = 0, CW_CODE = 1, CW_BAR = 4096;
constexpr size_t Z_MOD = 128 * KiB;
constexpr size_t Z_BIAS1 = 192 * KiB;
constexpr size_t Z_BIAS2 = 224 * KiB;
constexpr size_t Z_SSQS = 256 * KiB, Z_SSQ1 = 320 * KiB, Z_SSQ2 = 384 * KiB;
constexpr size_t Z_KSUM = 512 * KiB;
constexpr size_t Z_LCNT = 640 * KiB;
constexpr size_t WS_ROPE = 2 * MiB;
constexpr size_t WS_SSMP = 4 * MiB;
constexpr size_t WS_SST = 42 * MiB;
constexpr size_t SSM_BF = 0, SSM_CF = 128 * KiB, SSM_AP = 256 * KiB;
constexpr size_t WS_RSTD0 = 5 * MiB;
constexpr size_t WS_WIN = 6 * MiB, WS_WGLU = 14 * MiB, WS_WOUT = 15 * MiB, WS_W1 = 17 * MiB, WS_W2 = 33 * MiB;
constexpr size_t WS_XB = 48 * MiB;
constexpr size_t WS_Q = 80 * MiB, WS_K = 96 * MiB, WS_V = 112 * MiB, WS_U = 128 * MiB;
constexpr size_t WS_MIX = 144 * MiB;
constexpr size_t WS_Y = 176 * MiB;
constexpr size_t WS_H = 80 * MiB;
constexpr size_t WS_PO0 = 48 * MiB;
constexpr size_t WS_PO1 = 224 * MiB;
constexpr size_t WS_PML = 192 * MiB;
constexpr size_t WS_SEL = 196 * MiB;
constexpr size_t WS_LIST = 208 * MiB;
constexpr size_t WS_END = 256 * MiB;

constexpr int RING_OFF = 0, RING_BYTES = 131072;
constexpr int LDSCTL_OFF = RING_BYTES, MISC_OFF = LDSCTL_OFF + 320;
constexpr int LDS_BYTES = 147456;

struct Frame {
    LAS unsigned char* lds;
    volatile LAS unsigned* MISC;
    gu32* ctl;
    int tid, lane, wave, vcu, G;
};

__device__ __forceinline__ float wave_sum(float v) {
#pragma unroll
    for (int o = 1; o < 64; o <<= 1) v += __shfl_xor(v, o);
    return v;
}

__device__ __forceinline__ int qk_dst(int c) {
    if (c >= 1024) return c;
    const int hb = c & ~63, d = c & 63, dd = d & 31;
    return hb + 8 * (dd >> 2) + (d >> 5) * 4 + (dd & 3);
}
__device__ __forceinline__ void tr_item(const float* W, int N, int ksrc0, int n0, bf16* WT0, bf16* WT1, int ldk, int kdst0,
                                        const float* g, const float* sc0, const float* sc1, const float* sh0, const float* sh1, float* bias0, float* bias1,
                                        int gi0, bool qkperm, LAS float* scr, int lane) {
#pragma unroll 8
    for (int i = 0; i < 32; ++i) { const int kk = 2 * i + (lane >> 5); scr[kk * 33 + (lane & 31)] = W[(size_t)(ksrc0 + kk) * N + n0 + (lane & 31)]; }
    LDS_WAIT(); asm volatile("" ::: "memory");
    const int c = lane & 7;
    float s0[8], s1[8];
#pragma unroll
    for (int e = 0; e < 8; ++e) { const int gi = gi0 + 8 * c + e; const float gg = g ? g[gi] : 1.f; s0[e] = sc0 ? gg * (1.f + sc0[gi]) : gg; s1[e] = sc1 ? gg * (1.f + sc1[gi]) : gg; }
#pragma unroll
    for (int j = 0; j < 4; ++j) { const int n = (lane >> 3) + 8 * j; const LAS float* s = scr + (8 * c) * 33 + n;
        float f[8];
#pragma unroll
        for (int e = 0; e < 8; ++e) f[e] = s[e * 33];
        const int dr = qkperm ? qk_dst(n0 + n) : (n0 + n);
        v4u o; o.x = pk2(f[0] * s0[0], f[1] * s0[1]); o.y = pk2(f[2] * s0[2], f[3] * s0[3]); o.z = pk2(f[4] * s0[4], f[5] * s0[5]); o.w = pk2(f[6] * s0[6], f[7] * s0[7]);
        *(GAS v4u*)(WT0 + (size_t)dr * ldk + kdst0 + 8 * c) = o;
        if (WT1) { v4u p; p.x = pk2(f[0] * s1[0], f[1] * s1[1]); p.y = pk2(f[2] * s1[2], f[3] * s1[3]); p.z = pk2(f[4] * s1[4], f[5] * s1[5]); p.w = pk2(f[6] * s1[6], f[7] * s1[7]);
            *(GAS v4u*)(WT1 + (size_t)dr * ldk + kdst0 + 8 * c) = p; } }
    if (bias0) { const int nn = lane & 31, hf = lane >> 5; float p0 = 0.f, p1 = 0.f;
#pragma unroll 8
        for (int i = 0; i < 32; ++i) { const int kk = hf * 32 + i; const float w = scr[kk * 33 + nn]; p0 += sh0[gi0 + kk] * w; p1 += sh1[gi0 + kk] * w; }
        p0 += __shfl_xor(p0, 32); p1 += __shfl_xor(p1, 32);
        if (lane < 32) { const int dr = qkperm ? qk_dst(n0 + nn) : (n0 + nn); atomicAdd(bias0 + dr, p0); atomicAdd(bias1 + dr, p1); } }
    LDS_WAIT(); asm volatile("" ::: "memory");
}
__device__ __forceinline__ void xprep_row(const float* xrow, bf16* orow, float* rstd_out, int lane) {
    const GAS f32x4* xr = (const GAS f32x4*)xrow + lane;
    f32x4 v[4]; float s = 0.f;
#pragma unroll
    for (int j = 0; j < 4; ++j) { v[j] = xr[64 * j]; s += (v[j].x * v[j].x + v[j].y * v[j].y) + (v[j].z * v[j].z + v[j].w * v[j].w); }
    s = wave_sum(s);
    GAS unsigned long long* o8 = (GAS unsigned long long*)orow + lane;
#pragma unroll
    for (int j = 0; j < 4; ++j) o8[64 * j] = (unsigned long long)pk2(v[j].x, v[j].y) | ((unsigned long long)pk2(v[j].z, v[j].w) << 32);
    if (lane == 0) *rstd_out = 1.0f / sqrtf(s * (1.0f / D) + EPS);
}
__device__ __forceinline__ void mod_item(const float* c, const float* w_ada, const float* b_ada, float* mod, int it, int lane) {
    const int kc = it / 24, nc = it % 24, n0 = nc * 256 + lane * 4;
    f32x4 a0 = (f32x4){0.f, 0.f, 0.f, 0.f}, a1 = a0;
#pragma unroll 4
    for (int kk = 0; kk < 32; ++kk) { const int k = kc * 32 + kk; const f32x4 w = *(const GAS f32x4*)(w_ada + (size_t)k * 6144 + n0);
        const float c0 = c[k], c1 = c[D + k]; const float s0 = c0 / (1.f + expf(-c0)), s1 = c1 / (1.f + expf(-c1));
        a0 += w * s0; a1 += w * s1; }
    if (kc == 0) { const f32x4 bb = *(const f32x4*)(b_ada + n0); a0 += bb; a1 += bb; }
#pragma unroll
    for (int i = 0; i < 4; ++i) { atomicAdd(mod + n0 + i, a0[i]); atomicAdd(mod + 6144 + n0 + i, a1[i]); }
}


typedef float f32x16 __attribute__((ext_vector_type(16)));
typedef unsigned u32x2v __attribute__((ext_vector_type(2)));
constexpr int SSM_TC = 128, SSM_NCH = T / SSM_TC;
__device__ __forceinline__ int ssm_tau(int rho) { return 16 * ((rho >> 2) & 1) + (rho & 3) + 4 * (rho >> 3); }
struct cpx { float r, i; };
__device__ __forceinline__ cpx cmul(cpx a, cpx b) { return cpx{a.r * b.r - a.i * b.i, a.r * b.i + a.i * b.r}; }
__device__ __forceinline__ cpx cfma(cpx a, cpx x, float br, float bi) { return cpx{fmaf(a.r, x.r, fmaf(-a.i, x.i, br)), fmaf(a.r, x.i, fmaf(a.i, x.r, bi))}; }
__device__ __forceinline__ float gelu_tanh_f(float x) {
    const float z = x * fmaf(0.044715f * x, x, 1.0f) * (-2.0f * 0.7978845608028654f * 1.4426950408889634f);
    return x * __builtin_amdgcn_rcpf(1.0f + __builtin_amdgcn_exp2f(z));
}
__device__ __forceinline__ void ssm_prep(int idx, const float* lam_re, const float* lam_im, const float* log_dt, const float* b_re, const float* b_im, const float* c_re, const float* c_im,
                                         bf16* BF, bf16* CF, float* AP) {
    const int g = idx >> 6, p = idx & 63;
    const double lr = lam_re[idx], li = lam_im[idx], dt = exp((double)log_dt[g]);
    const double er = exp(lr * dt); double ar = er * cos(li * dt), ai = er * sin(li * dt);
    const double nr = ar - 1.0, ni = ai, den = lr * lr + li * li; const double fr = (nr * lr + ni * li) / den, fi = (ni * lr - nr * li) / den;
    float* ap = AP + (size_t)idx * 8; ap[0] = (float)ar; ap[1] = (float)ai;
    double pr = ar, pi = ai;
#pragma unroll 1
    for (int s = 0; s < 7; ++s) { const double t = pr * pr - pi * pi; pi = 2.0 * pr * pi; pr = t; if (s == 3) { ap[2] = (float)pr; ap[3] = (float)pi; } }
    ap[4] = (float)pr; ap[5] = (float)pi; ap[6] = 0.f; ap[7] = 0.f;
    const int r32 = p & 31, ctb = 2 * (p >> 5);
#pragma unroll 1
    for (int n = 0; n < 16; ++n) { const double br = b_re[(size_t)idx * 16 + n], bi = b_im[(size_t)idx * 16 + n];
        const float vr = (float)(fr * br - fi * bi), vi = (float)(fr * bi + fi * br); const int ln = r32 + 32 * (n >> 3), e = n & 7;
        BF[((size_t)(g * 4 + ctb) * 64 + ln) * 8 + e] = (bf16)f2bf(vr); BF[((size_t)(g * 4 + ctb + 1) * 64 + ln) * 8 + e] = (bf16)f2bf(vi);
        const float cr = c_re[((size_t)g * 16 + n) * 64 + p], ci = c_im[((size_t)g * 16 + n) * 64 + p];
#pragma unroll
        for (int part = 0; part < 2; ++part) { const int k = 2 * p + part, ks = k >> 5, fq = (k >> 3) & 3, ee = k & 7;
            CF[((size_t)(g * 4 + ks) * 64 + n + 16 * fq) * 8 + ee] = (bf16)f2bf(part ? -ci : cr); } }
}
#define MFMA32(a, b, c) __builtin_amdgcn_mfma_f32_32x32x16_bf16((a), (b), (c), 0, 0, 0)
#define MFMA16(a, b, c) __builtin_amdgcn_mfma_f32_16x16x32_bf16((a), (b), (c), 0, 0, 0)
__device__ __forceinline__ void ssm_stage1(int unit, const bf16* U, const bf16* BF, const float* AP, float* SST, int lane) {
    const int c = unit & 63, g = (unit >> 6) & 31, b = unit >> 11, r32 = lane & 31, hi = lane >> 5;
    bf16x8 bfr[4];
#pragma unroll
    for (int ct = 0; ct < 4; ++ct) bfr[ct] = *(const bf16x8*)(BF + ((size_t)(g * 4 + ct) * 64 + lane) * 8);
    const float* apA = AP + (size_t)(g * 64 + r32) * 8; const float* apB = apA + 32 * 8;
    const cpx aA{apA[0], apA[1]}, a16A{apA[2], apA[3]}, aB{apB[0], apB[1]}, a16B{apB[2], apB[3]};
    const bf16* ub = U + ((size_t)(b * T + c * SSM_TC + ssm_tau(r32))) * 512 + g * 16 + 8 * hi;
    bf16x8 uf[4];
#pragma unroll
    for (int st = 0; st < 4; ++st) uf[st] = *(const bf16x8*)(ub + (size_t)st * 32 * 512);
    cpx sA{0.f, 0.f}, sB{0.f, 0.f};
    const f32x16 z16 = {0.f, 0.f, 0.f, 0.f, 0.f, 0.f, 0.f, 0.f, 0.f, 0.f, 0.f, 0.f, 0.f, 0.f, 0.f, 0.f};
#pragma unroll
    for (int st = 0; st < 4; ++st) {
        const f32x16 d0 = MFMA32(uf[st], bfr[0], z16), d1 = MFMA32(uf[st], bfr[1], z16), d2 = MFMA32(uf[st], bfr[2], z16), d3 = MFMA32(uf[st], bfr[3], z16);
        sA = cmul(a16A, sA); sB = cmul(a16B, sB);
#pragma unroll
        for (int r = 0; r < 16; ++r) { sA = cfma(aA, sA, d0[r], d1[r]); sB = cfma(aB, sB, d2[r], d3[r]); }
    }
    const float pAr = __shfl_xor(sA.r, 32), pAi = __shfl_xor(sA.i, 32), pBr = __shfl_xor(sB.r, 32), pBi = __shfl_xor(sB.i, 32);
    if (hi == 0) { const cpx tA = cmul(a16A, sA), tB = cmul(a16B, sB);
        float* sp = SST + ((size_t)((b * 32 + g) * SSM_NCH + c) * 64) * 2;
        *(float2*)(sp + 2 * r32) = make_float2(tA.r + pAr, tA.i + pAi); *(float2*)(sp + 2 * (32 + r32)) = make_float2(tB.r + pBr, tB.i + pBi); }
}
__device__ __forceinline__ void ssm_stage2(int unit, const bf16* U, const bf16* BF, const bf16* CF, const float* AP, const float* dskip, const float* SST, bf16* Y, LAS unsigned* X, int lane) {
    const int c = unit & 63, g = (unit >> 6) & 31, b = unit >> 11, r32 = lane & 31, hi = lane >> 5, fr = lane & 15, fq = lane >> 4;
    bf16x8 bfr[4], cfr[4];
#pragma unroll
    for (int ct = 0; ct < 4; ++ct) { bfr[ct] = *(const bf16x8*)(BF + ((size_t)(g * 4 + ct) * 64 + lane) * 8); cfr[ct] = *(const bf16x8*)(CF + ((size_t)(g * 4 + ct) * 64 + lane) * 8); }
    const float* apA = AP + (size_t)(g * 64 + r32) * 8; const float* apB = apA + 32 * 8;
    const cpx aA{apA[0], apA[1]}, aB{apB[0], apB[1]}, atA{apA[4], apA[5]}, atB{apB[4], apB[5]};
    const f32x4 dsk = *(const f32x4*)(dskip + g * 16 + 4 * fq);
    const size_t row0 = (size_t)b * T + (size_t)c * SSM_TC;
    const bf16* ub = U + (row0 + ssm_tau(r32)) * 512 + g * 16 + 8 * hi;
    bf16x8 uf[4];
#pragma unroll
    for (int st = 0; st < 4; ++st) uf[st] = *(const bf16x8*)(ub + (size_t)st * 32 * 512);
    cpx xA{0.f, 0.f}, xB{0.f, 0.f};
    { const float* sp = SST + ((size_t)((b * 32 + g) * SSM_NCH) * 64) * 2;
      for (int cc = 0; cc < c; ++cc) { const float2 vA = *(const float2*)(sp + (size_t)cc * 128 + 2 * r32), vB = *(const float2*)(sp + (size_t)cc * 128 + 2 * (32 + r32));
          xA = cfma(atA, xA, vA.x, vA.y); xB = cfma(atB, xB, vB.x, vB.y); } }
    const f32x16 z16 = {0.f, 0.f, 0.f, 0.f, 0.f, 0.f, 0.f, 0.f, 0.f, 0.f, 0.f, 0.f, 0.f, 0.f, 0.f, 0.f};
#pragma unroll 1
    for (int st = 0; st < 4; ++st) {
        const f32x16 d0 = MFMA32(uf[st], bfr[0], z16), d1 = MFMA32(uf[st], bfr[1], z16), d2 = MFMA32(uf[st], bfr[2], z16), d3 = MFMA32(uf[st], bfr[3], z16);
        LAS unsigned* xw = X + (16 * hi) * 68 + r32;
        if (hi == 0) {
#pragma unroll
            for (int r = 0; r < 16; ++r) { xA = cfma(aA, xA, d0[r], d1[r]); xB = cfma(aB, xB, d2[r], d3[r]); xw[r * 68] = pg8::cvt_pk_bf16(xA.r, xA.i); xw[r * 68 + 32] = pg8::cvt_pk_bf16(xB.r, xB.i); }
        }
        { const float mAr = __shfl_xor(xA.r, 32), mAi = __shfl_xor(xA.i, 32), mBr = __shfl_xor(xB.r, 32), mBi = __shfl_xor(xB.i, 32);
          if (hi == 1) { xA = cpx{mAr, mAi}; xB = cpx{mBr, mBi}; } }
        if (hi == 1) {
#pragma unroll
            for (int r = 0; r < 16; ++r) { xA = cfma(aA, xA, d0[r], d1[r]); xB = cfma(aB, xB, d2[r], d3[r]); xw[r * 68] = pg8::cvt_pk_bf16(xA.r, xA.i); xw[r * 68 + 32] = pg8::cvt_pk_bf16(xB.r, xB.i); }
        }
        { const float mAr = __shfl_xor(xA.r, 32), mAi = __shfl_xor(xA.i, 32), mBr = __shfl_xor(xB.r, 32), mBi = __shfl_xor(xB.i, 32);
          if (hi == 0) { xA = cpx{mAr, mAi}; xB = cpx{mBr, mBi}; } }
        asm volatile("s_waitcnt lgkmcnt(0)" ::: "memory");
#pragma unroll
        for (int tl = 0; tl < 2; ++tl) {
            f32x4 acc = {0.f, 0.f, 0.f, 0.f};
#pragma unroll
            for (int ks = 0; ks < 4; ++ks) { const bf16x8 xf = *(const LAS bf16x8*)((const LAS unsigned char*)X + (16 * tl + fr) * 272 + (32 * ks + 8 * fq) * 2); acc = MFMA16(cfr[ks], xf, acc); }
            const size_t row = row0 + st * 32 + 16 * tl + fr;
            const u32x2v uw = *(const u32x2v*)(U + row * 512 + g * 16 + 4 * fq);
            const f32x4 uu = {pg8::bflo(uw.x), pg8::bfhi(uw.x), pg8::bflo(uw.y), pg8::bfhi(uw.y)};
            f32x4 y = acc + dsk * uu;
#pragma unroll
            for (int i = 0; i < 4; ++i) y[i] = gelu_tanh_f(y[i]);
            *(u32x2v*)(Y + row * 512 + g * 16 + 4 * fq) = pg8::pk4(y);
        }
        asm volatile("s_waitcnt lgkmcnt(0)" ::: "memory");
    }
}


typedef short v4i16_t __attribute__((ext_vector_type(4)));
__device__ __forceinline__ void gate_unit(int u, const bf16* Qb, const float* ksum, unsigned* lcnt, unsigned* list, unsigned char* selinfo, int wave, int lane) {
    const int i = u & 31, h = (u >> 5) & 7, b = u >> 8, r32 = lane & 31, hi = lane >> 5;
    const int row = b * T + 256 * i + 32 * wave + r32;
    float q[32];
    { const v4u* qp = (const v4u*)(Qb + (size_t)row * 512 + h * 64 + 32 * hi);
#pragma unroll
      for (int c = 0; c < 4; ++c) { const v4u w = qp[c];
          q[8 * c + 0] = pg8::bflo(w.x); q[8 * c + 1] = pg8::bfhi(w.x); q[8 * c + 2] = pg8::bflo(w.y); q[8 * c + 3] = pg8::bfhi(w.y);
          q[8 * c + 4] = pg8::bflo(w.z); q[8 * c + 5] = pg8::bfhi(w.z); q[8 * c + 6] = pg8::bflo(w.w); q[8 * c + 7] = pg8::bfhi(w.w); } }
    float g1 = -INFINITY, g2 = -INFINITY, g3 = -INFINITY; int i1 = -1, i2 = -1, i3 = -1;
    for (int n = 0; n < i; ++n) {
        const f32x4* kp = (const f32x4*)(ksum + ((size_t)((b * 8 + h) * 32 + n)) * 64 + 32 * hi); float part = 0.f;
#pragma unroll
        for (int c = 0; c < 8; ++c) { const f32x4 kv = kp[c]; part += q[4 * c] * kv.x + q[4 * c + 1] * kv.y + q[4 * c + 2] * kv.z + q[4 * c + 3] * kv.w; }
        const float full = part + __shfl_xor(part, 32);
        if (full > g1) { g3 = g2; i3 = i2; g2 = g1; i2 = i1; g1 = full; i1 = n; }
        else if (full > g2) { g3 = g2; i3 = i2; g2 = full; i2 = n; }
        else if (full > g3) { g3 = full; i3 = n; }
    }
    if (hi == 0) {
        const int nsel = i < 3 ? i : 3;
        if (i1 >= 0) { const int li = (b * 8 + h) * 32 + i1; const unsigned pos = atomicAdd(lcnt + li, 1u); list[(size_t)li * 8192 + pos] = (unsigned)row | (0u << 16); }
        if (i2 >= 0) { const int li = (b * 8 + h) * 32 + i2; const unsigned pos = atomicAdd(lcnt + li, 1u); list[(size_t)li * 8192 + pos] = (unsigned)row | (1u << 16); }
        if (i3 >= 0) { const int li = (b * 8 + h) * 32 + i3; const unsigned pos = atomicAdd(lcnt + li, 1u); list[(size_t)li * 8192 + pos] = (unsigned)row | (2u << 16); }
        selinfo[(size_t)row * 8 + h] = (unsigned char)nsel;
    }
}
constexpr int AT_KOFF = 0, AT_KPITCH = 144, AT_VOFF = 256 * 144, AT_LDS_END = AT_VOFF + 32768;
__device__ __forceinline__ void attn_unit(bool diag, int bh, int j, int q0, int cnt, const unsigned* list, const bf16* Qb, const bf16* Kb, const bf16* Vb,
                                          bf16* PO0, bf16* PO1, float* PML, LAS unsigned char* lds, int tid, int wave, int lane) {
    const int b = bh >> 3, h = bh & 7, r32 = lane & 31, hi = lane >> 5;
    const size_t rowbase = (size_t)b * T + 256 * j;
#pragma unroll
    for (int it = 0; it < 4; ++it) { const int cidx = tid + 512 * it, key = cidx >> 3, ch = cidx & 7;
        const v4u kv = *(const v4u*)(Kb + (rowbase + key) * 512 + h * 64 + ch * 8), vv = *(const v4u*)(Vb + (rowbase + key) * 512 + h * 64 + ch * 8);
        *(LAS v4u*)(lds + AT_KOFF + key * AT_KPITCH + ch * 16) = kv; *(LAS v4u*)(lds + AT_VOFF + (ch >> 2) * 16384 + key * 64 + (ch & 3) * 16) = vv; }
    __syncthreads();
    if (32 * wave < cnt) {
        const int qi = 32 * wave + r32; const bool valid = qi < cnt;
        int row, slot;
        if (diag) { row = (int)rowbase + qi; slot = 3; } else { const unsigned e = list[q0 + (valid ? qi : cnt - 1)]; row = (int)(e & 0xffffu); slot = (int)(e >> 16); }
        bf16x8 qf[4];
#pragma unroll
        for (int d0 = 0; d0 < 4; ++d0) qf[d0] = *(const bf16x8*)(Qb + (size_t)row * 512 + h * 64 + 16 * d0 + 8 * hi);
        const int nkt = diag ? wave + 1 : 8;
        f32x16 sc[8];
        const f32x16 z16 = {0.f, 0.f, 0.f, 0.f, 0.f, 0.f, 0.f, 0.f, 0.f, 0.f, 0.f, 0.f, 0.f, 0.f, 0.f, 0.f};
        float mx = -INFINITY;
#pragma unroll
        for (int kt = 0; kt < 8; ++kt) {
            if (kt < nkt) {
                f32x16 acc = z16;
#pragma unroll
                for (int d0 = 0; d0 < 4; ++d0) { const bf16x8 kf = *(const LAS bf16x8*)(lds + AT_KOFF + (32 * kt + r32) * AT_KPITCH + (16 * d0 + 8 * hi) * 2); acc = MFMA32(kf, qf[d0], acc); }
                if (diag && kt == wave) {
#pragma unroll
                    for (int r = 0; r < 16; ++r) { const int kl = (r & 3) + 8 * (r >> 2) + 4 * hi; if (kl > r32) acc[r] = -INFINITY; }
                }
#pragma unroll
                for (int r = 0; r < 16; ++r) mx = fmaxf(mx, acc[r]);
                sc[kt] = acc;
            } else sc[kt] = z16;
        }
        mx = fmaxf(mx, __shfl_xor(mx, 32));
        float l = 0.f; bf16x8 pb[8][2];
#pragma unroll
        for (int kt = 0; kt < 8; ++kt) {
            if (kt < nkt) {
                float p[16];
#pragma unroll
                for (int r = 0; r < 16; ++r) { p[r] = __builtin_amdgcn_exp2f(sc[kt][r] - mx); l += p[r]; }
#pragma unroll
                for (int s = 0; s < 2; ++s) { v4u w; w.x = pg8::cvt_pk_bf16(p[8 * s], p[8 * s + 1]); w.y = pg8::cvt_pk_bf16(p[8 * s + 2], p[8 * s + 3]); w.z = pg8::cvt_pk_bf16(p[8 * s + 4], p[8 * s + 5]); w.w = pg8::cvt_pk_bf16(p[8 * s + 6], p[8 * s + 7]);
                    pb[kt][s] = __builtin_bit_cast(bf16x8, w); }
            } else { pb[kt][0] = (bf16x8){0, 0, 0, 0, 0, 0, 0, 0}; pb[kt][1] = (bf16x8){0, 0, 0, 0, 0, 0, 0, 0}; }
        }
        l += __shfl_xor(l, 32);
        f32x16 o[2] = {z16, z16};
        const LAS unsigned char* vb = lds + AT_VOFF + (((lane & 15) >> 2) + 4 * hi) * 64 + (16 * ((lane >> 4) & 1) + 4 * (lane & 3)) * 2;
#pragma unroll
        for (int kt = 0; kt < 8; ++kt) {
            if (kt < nkt) {
#pragma unroll
                for (int s = 0; s < 2; ++s)
#pragma unroll
                    for (int dt = 0; dt < 2; ++dt) {
                        const LAS unsigned char* vp = vb + dt * 16384 + (32 * kt + 16 * s) * 64;
                        const v4i16_t lo = __builtin_amdgcn_ds_read_tr16_b64_v4i16((LAS v4i16_t*)vp), hh = __builtin_amdgcn_ds_read_tr16_b64_v4i16((LAS v4i16_t*)(vp + 512));
                        const bf16x8 vf = {lo[0], lo[1], lo[2], lo[3], hh[0], hh[1], hh[2], hh[3]};
                        o[dt] = MFMA32(vf, pb[kt][s], o[dt]);
                    }
            }
        }
        if (valid) {
            const float il = 1.0f / l;
            bf16* po = (slot < 2 ? PO0 : PO1) + (((size_t)row * 8 + h) * 2 + (slot & 1)) * 64;
#pragma unroll
            for (int dt = 0; dt < 2; ++dt)
#pragma unroll
                for (int g4 = 0; g4 < 4; ++g4) { const f32x4 v = {o[dt][4 * g4] * il, o[dt][4 * g4 + 1] * il, o[dt][4 * g4 + 2] * il, o[dt][4 * g4 + 3] * il};
                    *(pg8::u32x2*)(po + 32 * dt + 8 * g4 + 4 * hi) = pg8::pk4(v); }
            if (hi == 0) *(float2*)(PML + (((size_t)row * 8 + h) * 4 + slot) * 2) = make_float2(mx, l);
        }
    }
    __syncthreads();
}
__device__ __forceinline__ void combine_row(int row, const bf16* PO0, const bf16* PO1, const float* PML, const unsigned char* selinfo, bf16* MIX, int lane) {
    const int h = lane >> 3, c8 = lane & 7; const int nsel = selinfo[(size_t)row * 8 + h];
    const float2* ml = (const float2*)(PML + ((size_t)row * 8 + h) * 8);
    float2 m[4];
#pragma unroll
    for (int s = 0; s < 4; ++s) m[s] = ml[s];
    float Mx = m[3].x;
#pragma unroll
    for (int s = 0; s < 3; ++s) if (s < nsel) Mx = fmaxf(Mx, m[s].x);
    float acc[8]; float wsum = 0.f;
#pragma unroll
    for (int e = 0; e < 8; ++e) acc[e] = 0.f;
#pragma unroll
    for (int s = 0; s < 4; ++s) {
        if (s == 3 || s < nsel) { const float w = m[s].y * __builtin_amdgcn_exp2f(m[s].x - Mx); wsum += w;
            const v4u ow = *(const v4u*)((s < 2 ? PO0 : PO1) + (((size_t)row * 8 + h) * 2 + (s & 1)) * 64 + 8 * c8);
            acc[0] += w * pg8::bflo(ow.x); acc[1] += w * pg8::bfhi(ow.x); acc[2] += w * pg8::bflo(ow.y); acc[3] += w * pg8::bfhi(ow.y);
            acc[4] += w * pg8::bflo(ow.z); acc[5] += w * pg8::bfhi(ow.z); acc[6] += w * pg8::bflo(ow.w); acc[7] += w * pg8::bfhi(ow.w); }
    }
    const float iw = 1.0f / wsum; float ss = 0.f;
#pragma unroll
    for (int e = 0; e < 8; ++e) { acc[e] *= iw; ss += acc[e] * acc[e]; }
    ss = wave_sum(ss); const float rs = 1.0f / sqrtf(ss * (1.0f / 512.0f) + EPS);
    const f32x4 a0 = {acc[0] * rs, acc[1] * rs, acc[2] * rs, acc[3] * rs}, a1 = {acc[4] * rs, acc[5] * rs, acc[6] * rs, acc[7] * rs};
    *(pg8::u32x4*)(MIX + (size_t)row * 1024 + 512 + h * 64 + 8 * c8) = pg8::pk8(a0, a1);
}

struct Args { const float* in[23]; float* out; unsigned char* ws; int ph_lo, ph_hi, li, pad; };

__global__ void __launch_bounds__(NWAVES * 64, 2) skel_fwd(Args args) {
    extern __shared__ __attribute__((aligned(16))) unsigned char lds[];
    Frame F;
    F.lds = (LAS unsigned char*)lds;
    F.MISC = (volatile LAS unsigned*)(F.lds + MISC_OFF);
    F.tid = threadIdx.x; F.lane = F.tid & 63; F.wave = __builtin_amdgcn_readfirstlane(F.tid >> 6);
    F.G = gridDim.x; { const int bx = blockIdx.x; F.vcu = (F.G % 8 == 0) ? (bx % 8) * (F.G / 8) + bx / 8 : bx; }
    unsigned char* ws = args.ws;
    F.ctl = (gu32*)(ws + WS_CTL);
    const float* x = args.in[0]; const float* cvec = args.in[1]; const float* w_ada = args.in[2]; const float* b_ada = args.in[3]; const float* g_mix = args.in[4];
    const float* w_in = args.in[5]; const float* g_attn = args.in[6]; const float* w_glu = args.in[15]; const float* b_glu = args.in[16]; const float* g_ssm = args.in[17];
    const float* w_out = args.in[18]; const float* g_mlp = args.in[19]; const float* w_fc1 = args.in[20]; const float* w_fc2 = args.in[21]; const float* g_final = args.in[22];
    const float* lam_re = args.in[7]; const float* lam_im = args.in[8]; const float* log_dt = args.in[9]; const float* b_re = args.in[10]; const float* b_im = args.in[11];
    const float* c_re = args.in[12]; const float* c_im = args.in[13]; const float* d_skip = args.in[14];
    float* out = args.out;
    float* mod = (float*)(ws + Z_MOD); float* bias1 = (float*)(ws + Z_BIAS1); float* bias2 = (float*)(ws + Z_BIAS2);
    float* ssqs = (float*)(ws + Z_SSQS); float* ssq1 = (float*)(ws + Z_SSQ1); float* ssq2 = (float*)(ws + Z_SSQ2); float* ksum = (float*)(ws + Z_KSUM);
    float* rope = (float*)(ws + WS_ROPE); float* rstd0 = (float*)(ws + WS_RSTD0);
    bf16* WinT = (bf16*)(ws + WS_WIN); bf16* WgluT = (bf16*)(ws + WS_WGLU); bf16* WoutT = (bf16*)(ws + WS_WOUT); bf16* W1T = (bf16*)(ws + WS_W1); bf16* W2T = (bf16*)(ws + WS_W2);
    bf16* XB = (bf16*)(ws + WS_XB); bf16* Qb = (bf16*)(ws + WS_Q); bf16* Kb = (bf16*)(ws + WS_K); bf16* Vb = (bf16*)(ws + WS_V); bf16* Ub = (bf16*)(ws + WS_U);
    bf16* MIX = (bf16*)(ws + WS_MIX); bf16* Yb = (bf16*)(ws + WS_Y); bf16* Hb = (bf16*)(ws + WS_H);
    unsigned* lcnt = (unsigned*)(ws + Z_LCNT); unsigned* list = (unsigned*)(ws + WS_LIST); unsigned char* selinfo = ws + WS_SEL; float* PML = (float*)(ws + WS_PML);
    bf16* PO0 = (bf16*)(ws + WS_PO0); bf16* PO1 = (bf16*)(ws + WS_PO1);
    bf16* BF = (bf16*)(ws + WS_SSMP + SSM_BF); bf16* CF = (bf16*)(ws + WS_SSMP + SSM_CF); float* AP = (float*)(ws + WS_SSMP + SSM_AP); float* SST = (float*)(ws + WS_SST);

    for (int u = F.tid; u < (LDS_BYTES - LDSCTL_OFF) / 4; u += NWAVES * 64) ((LAS unsigned*)(F.lds + LDSCTL_OFF))[u] = 0u;
    __syncthreads();
    XcdBarrier bar = xcd_barrier_post((unsigned*)(F.ctl + CW_BAR) + args.li * XCD_BAR_WORDS, F.MISC + 8);
#define GRID_BAR() xcd_barrier(bar)
    const int lo = args.ph_lo, hi = args.ph_hi;
#define IN(k) (lo <= (k) && (k) < hi)
#define BOTH(k) (IN(k) && IN((k) + 1))
    const int gw = F.vcu * NWAVES + F.wave, NGW = F.G * NWAVES;
    LAS float* scr = (LAS float*)(F.lds + RING_OFF + F.wave * 16384);

    if (IN(0)) {
        for (int it = gw; it < 768; it += NGW) mod_item(cvec, w_ada, b_ada, mod, it, F.lane);
        constexpr int I_GLU = 8 * 16, I_OUT = 2 * 8 * 32, I_W2 = 64 * 32, I_ALL = I_GLU + I_OUT + I_W2;
        for (int it0 = gw; it0 < I_ALL; it0 += NGW) {
            int it = (it0 + 768) % I_ALL;
            if (it < I_GLU) { const int kb = it / 16, nb = it % 16; tr_item(w_glu, 512, 64 * kb, 32 * nb, WgluT, nullptr, 512, 64 * kb, nullptr, nullptr, nullptr, nullptr, nullptr, nullptr, nullptr, 0, false, scr, F.lane); continue; }
            it -= I_GLU;
            if (it < I_OUT) { const int hf = it / 256, r = it % 256, kb = r / 32, nb = r % 32;
                if (hf == 0) tr_item(w_out, 1024, 512 + 64 * kb, 32 * nb, WoutT, nullptr, 1024, 64 * kb, g_ssm, nullptr, nullptr, nullptr, nullptr, nullptr, nullptr, 64 * kb, false, scr, F.lane);
                else         tr_item(w_out, 1024, 64 * kb, 32 * nb, WoutT, nullptr, 1024, 512 + 64 * kb, g_attn, nullptr, nullptr, nullptr, nullptr, nullptr, nullptr, 64 * kb, false, scr, F.lane);
                continue; }
            it -= I_OUT;
            { const int kb = it / 32, nb = it % 32; tr_item(w_fc2, 1024, 64 * kb, 32 * nb, W2T, nullptr, 4096, 64 * kb, nullptr, nullptr, nullptr, nullptr, nullptr, nullptr, nullptr, 0, false, scr, F.lane); }
        }
        for (int idx = blockIdx.x * (NWAVES * 64) + F.tid; idx < T * 32; idx += F.G * NWAVES * 64) { const int t = idx >> 5, d = idx & 31;
            const float inv = powf(10000.f, -(float)d / 32.f); const float ang = (float)t * inv; const float sn = sinf(ang), cs = cosf(ang);
            float* rp = rope + ((size_t)t * 8 + (d >> 2)) * 8 + (d & 3); rp[0] = cs; rp[4] = sn; }
        { const int idx = blockIdx.x * (NWAVES * 64) + F.tid; if (idx < 32 * 64) ssm_prep(idx, lam_re, lam_im, log_dt, b_re, b_im, c_re, c_im, BF, CF, AP); }
        for (int m = gw; m < M; m += NGW) xprep_row(x + (size_t)m * D, XB + (size_t)m * D, rstd0 + m, F.lane);
        if (BOTH(0)) GRID_BAR();
    }
    if (IN(1)) {
        constexpr int I_IN = 16 * 64, I_W1 = 16 * 128;
        const float *sh1 = mod, *sc1 = mod + D, *sh2 = mod + 3 * D, *sc2 = mod + 4 * D;
        for (int it0 = gw; it0 < I_IN + I_W1; it0 += NGW) {
            int it = it0;
            if (it < I_IN) { const int kb = it / 64, nb = it % 64;
                tr_item(w_in, NPROJ, 64 * kb, 32 * nb, WinT, WinT + (size_t)NPROJ * D, D, 64 * kb, g_mix, sc1, sc1 + 6144, sh1, sh1 + 6144, bias1, bias1 + NPROJ, 64 * kb, true, scr, F.lane); continue; }
            it -= I_IN;
            { const int kb = it / 128, nb = it % 128;
                tr_item(w_fc1, FF, 64 * kb, 32 * nb, W1T, W1T + (size_t)FF * D, D, 64 * kb, g_mlp, sc2, sc2 + 6144, sh2, sh2 + 6144, bias2, bias2 + FF, 64 * kb, false, scr, F.lane); }
        }
        if (BOTH(1)) GRID_BAR();
    }
    if (IN(2)) {
        pg8::Gemm g{XB, WinT, M, NPROJ, D, (size_t)NPROJ * D * 2, -1}; pg8::StaticOrder S; S.init(M, NPROJ, F.G, (int)blockIdx.x);
        pg8::EpiProj E{rstd0, bias1, rope, Qb, Kb, Vb, Ub, ksum, C2};
        pg8::gemm_phase<pg8::EpiProj, pg8::StaticOrder, true, true>(F.lds + RING_OFF, g, S, E);
        if (BOTH(2)) GRID_BAR();
    }
    if (IN(3)) {
        for (int u = gw; u < 2 * 32 * SSM_NCH; u += NGW) ssm_stage1(u, Ub, BF, AP, SST, F.lane);
        for (int u = blockIdx.x; u < 512; u += F.G) gate_unit(u, Qb, ksum, lcnt, list, selinfo, F.wave, F.lane);
        if (BOTH(3)) GRID_BAR();
    }
    if (IN(4)) {
        for (int u = gw; u < 2 * 32 * SSM_NCH; u += NGW) ssm_stage2(u, Ub, BF, CF, AP, d_skip, SST, Yb, (LAS unsigned*)(F.lds + RING_OFF + F.wave * 16384), F.lane);
        __syncthreads();
        {
            LAS int* pre = (LAS int*)(F.lds + 120 * 1024);
            if (F.tid < 512) pre[F.tid] = (int)((lcnt[F.tid] + 255u) >> 8);
            __syncthreads();
            if (F.tid == 0) { int s = 0; for (int k = 0; k < 512; ++k) { const int v = pre[k]; pre[k] = s; s += v; } pre[512] = s; }
            __syncthreads();
            const int total = 512 + pre[512];
            for (int u = blockIdx.x; u < total; u += F.G) {
                if (u < 512) { attn_unit(true, u >> 5, u & 31, 0, 256, nullptr, Qb, Kb, Vb, PO0, PO1, PML, F.lds, F.tid, F.wave, F.lane); }
                else { const int v = u - 512; int lo_ = 0, hi_ = 511;
                    while (lo_ < hi_) { const int mid = (lo_ + hi_ + 1) >> 1; if (pre[mid] <= v) lo_ = mid; else hi_ = mid - 1; }
                    const int chunk = v - pre[lo_]; const int cn = (int)lcnt[lo_] - 256 * chunk;
                    attn_unit(false, lo_ >> 5, lo_ & 31, 256 * chunk, cn < 256 ? cn : 256, list + (size_t)lo_ * 8192, Qb, Kb, Vb, PO0, PO1, PML, F.lds, F.tid, F.wave, F.lane); }
            }
        }
        if (BOTH(4)) GRID_BAR();
    }
    if (IN(5)) {
        for (int m = gw; m < M; m += NGW) combine_row(m, PO0, PO1, PML, selinfo, MIX, F.lane);
        pg8::Gemm g{Yb, WgluT, M, 512, 512, 0, -1}; pg8::StaticOrder S; S.init(M, 512, F.G, (int)blockIdx.x);
        pg8::EpiGlu E{Yb, b_glu, MIX, ssqs};
        pg8::gemm_phase<pg8::EpiGlu, pg8::StaticOrder, false, true>(F.lds + RING_OFF, g, S, E);
        if (BOTH(5)) GRID_BAR();
    }
    if (IN(6)) {
        pg8::Gemm g{MIX, WoutT, M, D, D, 0, 8}; pg8::StaticOrder S; S.init(M, D, F.G, (int)blockIdx.x);
        pg8::EpiOut E{x, mod + 2 * D, out, XB, ssq1, ssqs};
        pg8::gemm_phase<pg8::EpiOut, pg8::StaticOrder, false, true>(F.lds + RING_OFF, g, S, E);
        if (BOTH(6)) GRID_BAR();
    }
    if (IN(7)) {
        pg8::Gemm g{XB, W1T, M, FF, D, (size_t)FF * D * 2, -1}; pg8::StaticOrder S; S.init(M, FF, F.G, (int)blockIdx.x);
        pg8::EpiFc1 E{ssq1, bias2, Hb};
        pg8::gemm_phase<pg8::EpiFc1, pg8::StaticOrder, true, true>(F.lds + RING_OFF, g, S, E);
        if (BOTH(7)) GRID_BAR();
    }
    if (IN(8)) {
        pg8::Gemm g{Hb, W2T, M, D, FF, 0, -1}; pg8::StaticOrder S; S.init(M, D, F.G, (int)blockIdx.x);
        pg8::EpiFc2 E{mod + 5 * D, out, ssq2};
        pg8::gemm_phase<pg8::EpiFc2, pg8::StaticOrder, false, true>(F.lds + RING_OFF, g, S, E);
        if (BOTH(8)) GRID_BAR();
    }
    if (IN(9)) {
        for (int m = gw; m < M; m += NGW) { GAS f32x4* o = (GAS f32x4*)(out + (size_t)m * D) + F.lane; const float rs = 1.0f / sqrtf(ssq2[m] * (1.0f / D) + EPS);
#pragma unroll
            for (int j = 0; j < 4; ++j) { const f32x4 gg = *(const f32x4*)(g_final + 4 * F.lane + 256 * j); o[64 * j] = o[64 * j] * rs * gg; } }
    }
#undef IN
#undef BOTH
#undef GRID_BAR
}

extern "C" void kernel_launch(void* const* d_in, const int* in_sizes, int n_in, void* d_out, int out_size, void* d_ws, size_t ws_size, hipStream_t stream) {
    static int grid = 0;
    if (grid == 0) {
        if (n_in != 23 || in_sizes[0] != M * D || out_size != M * D || ws_size < WS_END) { fprintf(stderr, "kernel_launch: unexpected shapes (n_in %d, in0 %d, out %d, ws %zu)\n", n_in, n_in > 0 ? in_sizes[0] : -1, out_size, ws_size); grid = -1; return; }
        int dev = 0, cus = 0, per_cu = 0;
        if (hipGetDevice(&dev) != hipSuccess || hipDeviceGetAttribute(&cus, hipDeviceAttributeMultiprocessorCount, dev) != hipSuccess) { grid = -1; return; }
        if (hipFuncSetAttribute((const void*)skel_fwd, hipFuncAttributeMaxDynamicSharedMemorySize, LDS_BYTES) != hipSuccess) { fprintf(stderr, "kernel_launch: hipFuncSetAttribute failed\n"); grid = -1; return; }
        if (hipOccupancyMaxActiveBlocksPerMultiprocessor(&per_cu, (const void*)skel_fwd, NWAVES * 64, LDS_BYTES) != hipSuccess || per_cu < 1) { fprintf(stderr, "kernel_launch: occupancy query says %d\n", per_cu); per_cu = 1; }
        (void)hipGetLastError();
        grid = cus;
        if (grid != 256) fprintf(stderr, "kernel_launch: %d CUs (expected 256)\n", grid);
    }
    if (grid < 0) return;
    hipMemsetAsync((char*)d_ws + WS_CTL, 0, CTL_ZERO_BYTES, stream);
    Args a{};
    for (int i = 0; i < 23; ++i) a.in[i] = (const float*)d_in[i];
    a.out = (float*)d_out; a.ws = (unsigned char*)d_ws;
    a.ph_lo = 0; a.ph_hi = N_PHASES; a.li = 0;
    hipLaunchKernelGGL(skel_fwd, dim3(grid), dim3(NWAVES * 64), LDS_BYTES, stream, a);
}
```

```cpp
#include <hip/hip_runtime.h>
#include <hip/hip_bf16.h>
#include <cstdio>
#include <cstdint>

namespace pg8 {
#define PG8_LAS __attribute__((address_space(3)))
typedef unsigned short bf16_t;
typedef short bf16x8 __attribute__((ext_vector_type(8)));
typedef float f32x4 __attribute__((ext_vector_type(4)));
typedef unsigned u32x4 __attribute__((ext_vector_type(4)));
constexpr int BM = 256, BK = 64, HALF = 128, HTB = HALF * BK * 2  , STAGE_BYTES = 8 * HTB, NXCD = 8, WGM = 8;

__host__ __device__ __forceinline__ int lds_byte(int r, int c) { const int st = (r >> 4) * 2 + (c >> 5), rr = r & 15, cc = c & 31, ob = rr * 64 + cc * 2; return st * 1024 + (ob ^ (((ob >> 9) & 1) << 5)); }
__host__ __device__ __forceinline__ void stage_rc(int b, int& R, int& C) { const int st = b / 1024, sb = b % 1024, swz = sb ^ (((sb >> 9) & 1) << 5); R = (st >> 1) * 16 + swz / 64; C = (st & 1) * 32 + (swz % 64) / 2; }
__host__ __device__ __forceinline__ int perm32(int rho) { const int n = rho >> 4, i = rho & 15; return 8 * (i >> 2) + 4 * n + (i & 3); }

struct Unit { int pm, pn; };
struct Gemm { const bf16_t* A; const bf16_t* Bt; int M, N, K; size_t bbytes; int tmid; };

struct StaticOrder {
    int nM, nN, nwg, G, c;
    __host__ __device__ void init(int M, int N, int G_, int c_) { nM = M / BM; nN = N / BM; nwg = nM * nN; G = G_; c = c_; }
    __host__ __device__ bool next(int i, Unit& u) const {
        const long L = (long)i * G + c; if (L >= nwg) return false;
        int wgid = (int)L; { const int q = nwg / NXCD, r = nwg % NXCD, xcd = wgid % NXCD, off = wgid / NXCD; wgid = (xcd < r ? xcd * (q + 1) : r * (q + 1) + (xcd - r) * q) + off; }
        const int nig = WGM * nN, gid = wgid / nig, fm = gid * WGM, gsz = (nM - fm) < WGM ? (nM - fm) : WGM;
        u.pm = fm + ((wgid % nig) % gsz); u.pn = (wgid % nig) / gsz; return true;
    }
    __device__ __forceinline__ void a_ready(const Unit&) const {}
    __device__ __forceinline__ void done(const Unit&) const {}
};


__device__ __forceinline__ unsigned cvt_pk_bf16(float lo, float hi) { unsigned r; asm volatile("v_cvt_pk_bf16_f32 %0, %1, %2" : "=v"(r) : "v"(lo), "v"(hi)); return r; }

typedef unsigned u32x2 __attribute__((ext_vector_type(2)));
constexpr float RMS_EPS = 1e-6f;
__device__ __forceinline__ u32x2 pk4(const f32x4 v) { u32x2 w; w.x = cvt_pk_bf16(v[0], v[1]); w.y = cvt_pk_bf16(v[2], v[3]); return w; }
__device__ __forceinline__ u32x4 pk8(const f32x4 a, const f32x4 b) { u32x4 w; w.x = cvt_pk_bf16(a[0], a[1]); w.y = cvt_pk_bf16(a[2], a[3]); w.z = cvt_pk_bf16(b[0], b[1]); w.w = cvt_pk_bf16(b[2], b[3]); return w; }
__device__ __forceinline__ float bflo(unsigned w) { return __builtin_bit_cast(float, w << 16); }
__device__ __forceinline__ float bfhi(unsigned w) { return __builtin_bit_cast(float, w & 0xffff0000u); }

struct EpiProj {
    static constexpr bool PERM = true, AFTER_DRAIN = false, MID = false;
    const float* rstd; const float* bias; const float* rope; bf16_t* Q; bf16_t* Kk; bf16_t* V; bf16_t* U; float* ksum; float qscale;
    __device__ __forceinline__ void mid(f32x4 (&)[2][2][4][2], const Unit&, int, int) const {}
    __device__ __forceinline__ void operator()(const f32x4 (&acc)[2][2][4][2], const Unit& u, int wr, int wc, int fr, int fq) const {
        const int b = u.pm >> 5, sect = u.pn >> 1;
        const int lc = (u.pn & 1) * 256 + wc * 32 + 8 * fq;
        const float* bp = bias + b * 2048 + u.pn * 256 + wc * 32 + 8 * fq;
        f32x4 bv[2][2];
#pragma unroll
        for (int bj = 0; bj < 2; ++bj)
#pragma unroll
            for (int n = 0; n < 2; ++n) bv[bj][n] = *(const f32x4*)(bp + bj * 128 + 4 * n);
        const int row0 = u.pm * 256 + wr * 64 + fr;
        if (sect < 2) {
            bf16_t* Tn = sect == 0 ? Q : Kk; const float sc = sect == 0 ? qscale : 1.f;
            const int a = 4 * (wc & 1) + fq;
            f32x4 ks1[2], ks2[2];
#pragma unroll
            for (int bj = 0; bj < 2; ++bj) { ks1[bj] = (f32x4){0.f, 0.f, 0.f, 0.f}; ks2[bj] = (f32x4){0.f, 0.f, 0.f, 0.f}; }
#pragma unroll
            for (int ai = 0; ai < 2; ++ai)
#pragma unroll
                for (int m = 0; m < 4; ++m) {
                    const int r = row0 + ai * 128 + m * 16, t = r & 8191; const float rs = rstd[r];
                    const float* rp = rope + ((size_t)t * 8 + a) * 8; const f32x4 cs = *(const f32x4*)rp, sn = *(const f32x4*)(rp + 4);
#pragma unroll
                    for (int bj = 0; bj < 2; ++bj) {
                        const f32x4 x1 = acc[ai][bj][m][0] * rs + bv[bj][0], x2 = acc[ai][bj][m][1] * rs + bv[bj][1];
                        f32x4 o1 = x1 * cs - x2 * sn, o2 = x1 * sn + x2 * cs;
                        ks1[bj] += o1; ks2[bj] += o2;
                        o1 = o1 * sc; o2 = o2 * sc;
                        bf16_t* p = Tn + (size_t)r * 512 + ((lc + bj * 128) & ~63) + 4 * a;
                        *(u32x2*)p = pk4(o1); *(u32x2*)(p + 32) = pk4(o2);
                    }
                }
            if (sect == 1) {
#pragma unroll
                for (int bj = 0; bj < 2; ++bj)
#pragma unroll
                    for (int i = 0; i < 4; ++i) {
                        float s1 = ks1[bj][i], s2 = ks2[bj][i];
#pragma unroll
                        for (int o = 1; o < 16; o <<= 1) { s1 += __shfl_xor(s1, o); s2 += __shfl_xor(s2, o); }
                        if (fr == 0) { const int head = (lc + bj * 128) >> 6, blk = u.pm & 31; float* kp = ksum + ((size_t)((b * 8 + head) * 32 + blk)) * 64 + 4 * a + i;
                            atomicAdd(kp, s1); atomicAdd(kp + 32, s2); }
                    }
            }
        } else {
            bf16_t* Tn = sect == 2 ? V : U;
#pragma unroll
            for (int ai = 0; ai < 2; ++ai)
#pragma unroll
                for (int m = 0; m < 4; ++m) {
                    const int r = row0 + ai * 128 + m * 16; const float rs = rstd[r];
#pragma unroll
                    for (int bj = 0; bj < 2; ++bj) {
                        const f32x4 v0 = acc[ai][bj][m][0] * rs + bv[bj][0], v1 = acc[ai][bj][m][1] * rs + bv[bj][1];
                        *(u32x4*)(Tn + (size_t)r * 512 + lc + bj * 128) = pk8(v0, v1);
                    }
                }
        }
    }
};
struct EpiGlu {
    static constexpr bool PERM = true, AFTER_DRAIN = false, MID = false;
    const bf16_t* Y; const float* bg; bf16_t* MIX; float* ssq;
    __device__ __forceinline__ void mid(f32x4 (&)[2][2][4][2], const Unit&, int, int) const {}
    __device__ __forceinline__ void operator()(const f32x4 (&acc)[2][2][4][2], const Unit& u, int wr, int wc, int fr, int fq) const {
        const int c0 = u.pn * 256 + wc * 32 + 8 * fq, row0 = u.pm * 256 + wr * 64 + fr;
        f32x4 bv[2][2];
#pragma unroll
        for (int bj = 0; bj < 2; ++bj)
#pragma unroll
            for (int n = 0; n < 2; ++n) bv[bj][n] = *(const f32x4*)(bg + c0 + bj * 128 + 4 * n);
#pragma unroll
        for (int ai = 0; ai < 2; ++ai)
#pragma unroll
            for (int m = 0; m < 4; ++m) {
                const int r = row0 + ai * 128 + m * 16; float sq = 0.f;
#pragma unroll
                for (int bj = 0; bj < 2; ++bj) {
                    const u32x4 yw = *(const u32x4*)(Y + (size_t)r * 512 + c0 + bj * 128);
                    const f32x4 y0 = (f32x4){bflo(yw.x), bfhi(yw.x), bflo(yw.y), bfhi(yw.y)}, y1 = (f32x4){bflo(yw.z), bfhi(yw.z), bflo(yw.w), bfhi(yw.w)};
                    const f32x4 z0 = acc[ai][bj][m][0] + bv[bj][0], z1 = acc[ai][bj][m][1] + bv[bj][1];
                    f32x4 s0, s1;
#pragma unroll
                    for (int i = 0; i < 4; ++i) { s0[i] = y0[i] / (1.f + __expf(-z0[i])); s1[i] = y1[i] / (1.f + __expf(-z1[i])); sq += s0[i] * s0[i] + s1[i] * s1[i]; }
                    *(u32x4*)(MIX + (size_t)r * 1024 + c0 + bj * 128) = pk8(s0, s1);
                }
                sq += __shfl_xor(sq, 16); sq += __shfl_xor(sq, 32);
                if (fq == 0) atomicAdd(ssq + r, sq);
            }
    }
};
struct EpiOut {
    static constexpr bool PERM = true, AFTER_DRAIN = false, MID = true;
    const float* x; const float* gate; float* X1; bf16_t* XB2; float* ssq1; const float* ssqs;
    __device__ __forceinline__ void mid(f32x4 (&acc)[2][2][4][2], const Unit& u, int wr, int fr) const {
#pragma unroll
        for (int ai = 0; ai < 2; ++ai)
#pragma unroll
            for (int m = 0; m < 4; ++m) { const int r = u.pm * 256 + wr * 64 + fr + ai * 128 + m * 16; const float sv = 1.0f / sqrtf(ssqs[r] * (1.0f / 512.0f) + RMS_EPS);
#pragma unroll
                for (int bj = 0; bj < 2; ++bj)
#pragma unroll
                    for (int n = 0; n < 2; ++n) acc[ai][bj][m][n] = acc[ai][bj][m][n] * sv; }
    }
    __device__ __forceinline__ void operator()(const f32x4 (&acc)[2][2][4][2], const Unit& u, int wr, int wc, int fr, int fq) const {
        const int b = u.pm >> 5, c0 = u.pn * 256 + wc * 32 + 8 * fq, row0 = u.pm * 256 + wr * 64 + fr;
        f32x4 gv[2][2];
#pragma unroll
        for (int bj = 0; bj < 2; ++bj)
#pragma unroll
            for (int n = 0; n < 2; ++n) gv[bj][n] = *(const f32x4*)(gate + b * 6144 + c0 + bj * 128 + 4 * n);
#pragma unroll
        for (int ai = 0; ai < 2; ++ai)
#pragma unroll
            for (int m = 0; m < 4; ++m) {
                const int r = row0 + ai * 128 + m * 16; float sq = 0.f;
#pragma unroll
                for (int bj = 0; bj < 2; ++bj) {
                    const size_t off = (size_t)r * 1024 + c0 + bj * 128;
                    const f32x4 o0 = *(const f32x4*)(x + off) + gv[bj][0] * acc[ai][bj][m][0], o1 = *(const f32x4*)(x + off + 4) + gv[bj][1] * acc[ai][bj][m][1];
                    *(f32x4*)(X1 + off) = o0; *(f32x4*)(X1 + off + 4) = o1;
                    *(u32x4*)(XB2 + off) = pk8(o0, o1);
#pragma unroll
                    for (int i = 0; i < 4; ++i) sq += o0[i] * o0[i] + o1[i] * o1[i];
                }
                sq += __shfl_xor(sq, 16); sq += __shfl_xor(sq, 32);
                if (fq == 0) atomicAdd(ssq1 + r, sq);
            }
    }
};
struct EpiFc1 {
    static constexpr bool PERM = true, AFTER_DRAIN = false, MID = false;
    const float* ssq1; const float* bias2; bf16_t* Hh;
    __device__ __forceinline__ void mid(f32x4 (&)[2][2][4][2], const Unit&, int, int) const {}
    __device__ __forceinline__ void operator()(const f32x4 (&acc)[2][2][4][2], const Unit& u, int wr, int wc, int fr, int fq) const {
        const int b = u.pm >> 5, c0 = u.pn * 256 + wc * 32 + 8 * fq, row0 = u.pm * 256 + wr * 64 + fr;
        f32x4 bv[2][2];
#pragma unroll
        for (int bj = 0; bj < 2; ++bj)
#pragma unroll
            for (int n = 0; n < 2; ++n) bv[bj][n] = *(const f32x4*)(bias2 + b * 4096 + c0 + bj * 128 + 4 * n);
#pragma unroll
        for (int ai = 0; ai < 2; ++ai)
#pragma unroll
            for (int m = 0; m < 4; ++m) {
                const int r = row0 + ai * 128 + m * 16; const float rs = 1.0f / sqrtf(ssq1[r] * (1.0f / 1024.0f) + RMS_EPS);
#pragma unroll
                for (int bj = 0; bj < 2; ++bj) {
                    f32x4 v0 = acc[ai][bj][m][0] * rs + bv[bj][0], v1 = acc[ai][bj][m][1] * rs + bv[bj][1];
#pragma unroll
                    for (int i = 0; i < 4; ++i) { const float a0 = fmaxf(v0[i], 0.f), a1 = fmaxf(v1[i], 0.f); v0[i] = a0 * a0; v1[i] = a1 * a1; }
                    *(u32x4*)(Hh + (size_t)r * 4096 + c0 + bj * 128) = pk8(v0, v1);
                }
            }
    }
};
struct EpiFc2 {
    static constexpr bool PERM = true, AFTER_DRAIN = false, MID = false;
    const float* gate; const float* RIN; float* WOUT; size_t wmask; float* ssq2;
    __device__ __forceinline__ void mid(f32x4 (&)[2][2][4][2], const Unit&, int, int) const {}
    __device__ __forceinline__ void operator()(const f32x4 (&acc)[2][2][4][2], const Unit& u, int wr, int wc, int fr, int fq) const {
        const int b = u.pm >> 5, c0 = u.pn * 256 + wc * 32 + 8 * fq, row0 = u.pm * 256 + wr * 64 + fr;
        f32x4 gv[2][2];
#pragma unroll
        for (int bj = 0; bj < 2; ++bj)
#pragma unroll
            for (int n = 0; n < 2; ++n) gv[bj][n] = *(const f32x4*)(gate + b * 6144 + c0 + bj * 128 + 4 * n);
#pragma unroll
        for (int ai = 0; ai < 2; ++ai)
#pragma unroll
            for (int m = 0; m < 4; ++m) {
                const int r = row0 + ai * 128 + m * 16; float sq = 0.f;
#pragma unroll
                for (int bj = 0; bj < 2; ++bj) {
                    const size_t off = (size_t)r * 1024 + c0 + bj * 128;
                    const f32x4 o0 = *(const f32x4*)(RIN + off) + gv[bj][0] * acc[ai][bj][m][0], o1 = *(const f32x4*)(RIN + off + 4) + gv[bj][1] * acc[ai][bj][m][1];
                    *(f32x4*)(WOUT + (off & wmask)) = o0; *(f32x4*)(WOUT + (off & wmask) + 4) = o1;
#pragma unroll
                    for (int i = 0; i < 4; ++i) sq += o0[i] * o0[i] + o1[i] * o1[i];
                }
                sq += __shfl_xor(sq, 16); sq += __shfl_xor(sq, 32);
                if (fq == 0) atomicAdd(ssq2 + r, sq);
            }
    }
};

template <class Epi, class Sched, bool ALIGN_EPI = false, bool SP2 = false>
__device__ __forceinline__ void gemm_phase(PG8_LAS unsigned char* lds, const Gemm g, const Sched& S, const Epi& E) {
    const int tid = threadIdx.x, wid = __builtin_amdgcn_readfirstlane(tid >> 6), lane = tid & 63, wr = wid >> 2, wc = wid & 3, fr = lane & 15, fq = lane >> 4;
    const int K = g.K, nt = K / BK;
    unsigned voffA[2], voffB[2];
#pragma unroll
    for (int i = 0; i < 2; ++i) { int R, C; stage_rc(tid * 16 + i * 8192, R, C); const int Rb = Epi::PERM ? ((R & ~31) + perm32(R & 31)) : R;
        voffA[i] = (unsigned)(R * K + C) * 2u; voffB[i] = (unsigned)(Rb * K + C) * 2u; }
    const size_t kstep = (size_t)(BK * 2);
    const size_t hstep = (size_t)HALF * K * 2;
    const size_t tstep = 2 * hstep;
    const unsigned ldsw = (unsigned)wid * 1024u;
    const int aoff = lds_byte(wr * 64 + fr, fq * 8), boff = lds_byte(wc * 32 + fr, fq * 8);
#define PG8_SA(b, h) (((b) * 2 + (h)) * HTB)
#define PG8_SB(b, h) ((4 + (b) * 2 + (h)) * HTB)
#define PG8_STAGE(bufoff, gbase, voff) do { _Pragma("unroll") for (int _i = 0; _i < 2; ++_i) \
        __builtin_amdgcn_global_load_lds((const unsigned*)((const char*)(gbase) + (voff)[_i]), (PG8_LAS unsigned*)(lds + (bufoff) + ldsw + _i * 8192), 16, 0, 0); } while (0)
#define PG8_LDA(dst, b, h) do { _Pragma("unroll") for (int m = 0; m < 4; ++m) _Pragma("unroll") for (int k = 0; k < 2; ++k) dst[m][k] = *(const PG8_LAS bf16x8*)(lds + PG8_SA(b, h) + aoff + m * 2048 + k * 1024); } while (0)
#define PG8_LDB(dst, b, h) do { _Pragma("unroll") for (int n = 0; n < 2; ++n) _Pragma("unroll") for (int k = 0; k < 2; ++k) dst[n][k] = *(const PG8_LAS bf16x8*)(lds + PG8_SB(b, h) + boff + n * 2048 + k * 1024); } while (0)
#define PG8_MMA(ai, bj, At, Bt) do { __builtin_amdgcn_s_setprio(1); _Pragma("unroll") for (int m = 0; m < 4; ++m) _Pragma("unroll") for (int n = 0; n < 2; ++n) _Pragma("unroll") for (int k = 0; k < 2; ++k) \
        acc[ai][bj][m][n] = __builtin_amdgcn_mfma_f32_16x16x32_bf16(Bt[n][k], At[m][k], acc[ai][bj][m][n], 0, 0, 0); __builtin_amdgcn_s_setprio(0); } while (0)
#define PG8_WAIT_V(n) asm volatile("s_waitcnt vmcnt(" #n ")" ::: "memory")
#define PG8_WAIT_L(n) asm volatile("s_waitcnt lgkmcnt(" #n ")" ::: "memory")
#define PG8_BAR __builtin_amdgcn_s_barrier()
#define PG8_SCHED __builtin_amdgcn_sched_barrier(0)
    Unit cur, nxt; int ui = 0;
    if (!S.next(0, cur)) return;
    f32x4 acc[2][2][4][2];
#pragma unroll
    for (int a = 0; a < 2; ++a)
#pragma unroll
        for (int b = 0; b < 2; ++b)
#pragma unroll
            for (int m = 0; m < 4; ++m)
#pragma unroll
                for (int n = 0; n < 2; ++n) acc[a][b][m][n] = (f32x4){0.f, 0.f, 0.f, 0.f};
    bf16x8 At[4][2], B0[2][2], B1[2][2];
    const char* cA = (const char*)g.A + (size_t)cur.pm * tstep; const char* cB = (const char*)g.Bt + (size_t)(cur.pm >> 5) * g.bbytes + (size_t)cur.pn * tstep;
    S.a_ready(cur);
    if constexpr (SP2) {
        PG8_STAGE(PG8_SB(0, 0), cB, voffB); PG8_STAGE(PG8_SB(0, 1), cB + hstep, voffB); PG8_STAGE(PG8_SA(0, 0), cA, voffA); PG8_STAGE(PG8_SA(0, 1), cA + hstep, voffA);
        if (wr == 1) PG8_BAR;
        PG8_WAIT_V(2); PG8_BAR;
        PG8_STAGE(PG8_SB(1, 0), cB + kstep, voffB); PG8_STAGE(PG8_SA(1, 0), cA + kstep, voffA); PG8_STAGE(PG8_SB(1, 1), cB + hstep + kstep, voffB);
        PG8_WAIT_V(6); PG8_BAR;
    } else {
        PG8_STAGE(PG8_SB(0, 0), cB, voffB); PG8_STAGE(PG8_SA(0, 0), cA, voffA); PG8_STAGE(PG8_SB(0, 1), cB + hstep, voffB); PG8_STAGE(PG8_SA(0, 1), cA + hstep, voffA);
        if (wr == 1) PG8_BAR;
        PG8_WAIT_V(4); PG8_BAR;
        PG8_STAGE(PG8_SB(1, 0), cB + kstep, voffB); PG8_STAGE(PG8_SA(1, 0), cA + kstep, voffA); PG8_STAGE(PG8_SB(1, 1), cB + hstep + kstep, voffB);
        PG8_WAIT_V(6); PG8_BAR;
    }
    for (;;) {
        const bool has_next = S.next(ui + 1, nxt);
        const char* nA = has_next ? (const char*)g.A + (size_t)nxt.pm * tstep : cA; const char* nB = has_next ? (const char*)g.Bt + (size_t)(nxt.pm >> 5) * g.bbytes + (size_t)nxt.pn * tstep : cB;
        for (int t = 0; t < nt; t += 2) {
            const bool last = (t == nt - 2);
            if constexpr (Epi::MID) { if (t == g.tmid) E.mid(acc, cur, wr, fr); }
            const char* a1 = cA + (size_t)(t + 1) * kstep;
            const char* a2 = last ? nA : cA + (size_t)(t + 2) * kstep; const char* b2 = last ? nB : cB + (size_t)(t + 2) * kstep;
            const char* a3 = a2 + kstep; const char* b3 = b2 + kstep;
            if (last && has_next) S.a_ready(nxt);
            if constexpr (SP2) {
            PG8_LDB(B0, 0, 0); PG8_LDB(B1, 0, 1); PG8_SCHED; PG8_LDA(At, 0, 0); PG8_STAGE(PG8_SA(1, 1), a1 + hstep, voffA);
            PG8_WAIT_V(8); PG8_WAIT_L(0); PG8_BAR; PG8_MMA(0, 0, At, B0); PG8_MMA(0, 1, At, B1); PG8_BAR; PG8_SCHED;
            PG8_LDA(At, 0, 1); PG8_STAGE(PG8_SB(0, 0), b2, voffB); PG8_STAGE(PG8_SB(0, 1), b2 + hstep, voffB); PG8_STAGE(PG8_SA(0, 0), a2, voffA);
            PG8_WAIT_V(8); PG8_WAIT_L(0); PG8_BAR; PG8_MMA(1, 0, At, B0); PG8_MMA(1, 1, At, B1); PG8_BAR; PG8_SCHED;
            PG8_LDB(B0, 1, 0); PG8_LDB(B1, 1, 1); PG8_SCHED; PG8_LDA(At, 1, 0); PG8_STAGE(PG8_SA(0, 1), a2 + hstep, voffA);
            PG8_WAIT_V(8); PG8_WAIT_L(0); PG8_BAR; PG8_MMA(0, 0, At, B0); PG8_MMA(0, 1, At, B1); PG8_BAR; PG8_SCHED;
            PG8_LDA(At, 1, 1); PG8_STAGE(PG8_SB(1, 0), b3, voffB); PG8_STAGE(PG8_SB(1, 1), b3 + hstep, voffB); PG8_STAGE(PG8_SA(1, 0), a3, voffA);
            PG8_WAIT_V(8); PG8_WAIT_L(0); PG8_BAR; PG8_MMA(1, 0, At, B0); PG8_MMA(1, 1, At, B1); PG8_BAR; PG8_SCHED;
            } else {
            PG8_LDB(B0, 0, 0); PG8_SCHED; PG8_LDA(At, 0, 0); PG8_STAGE(PG8_SA(1, 1), a1 + hstep, voffA);
            PG8_WAIT_L(8); PG8_BAR; PG8_WAIT_L(0); PG8_MMA(0, 0, At, B0); PG8_BAR; PG8_SCHED;
            PG8_LDB(B1, 0, 1); PG8_STAGE(PG8_SB(0, 0), b2, voffB);
            PG8_BAR; PG8_WAIT_L(0); PG8_MMA(0, 1, At, B1); PG8_BAR;
            PG8_LDA(At, 0, 1); PG8_STAGE(PG8_SA(0, 0), a2, voffA);
            PG8_BAR; PG8_WAIT_L(0); PG8_MMA(1, 0, At, B0); PG8_BAR; PG8_SCHED;
            PG8_STAGE(PG8_SB(0, 1), b2 + hstep, voffB);
            PG8_WAIT_V(6); PG8_BAR; PG8_MMA(1, 1, At, B1); PG8_BAR;
            PG8_LDB(B0, 1, 0); PG8_SCHED; PG8_LDA(At, 1, 0); PG8_STAGE(PG8_SA(0, 1), a2 + hstep, voffA);
            PG8_WAIT_L(8); PG8_BAR; PG8_WAIT_L(0); PG8_MMA(0, 0, At, B0); PG8_BAR; PG8_SCHED;
            PG8_LDB(B1, 1, 1); PG8_STAGE(PG8_SB(1, 0), b3, voffB);
            PG8_BAR; PG8_WAIT_L(0); PG8_MMA(0, 1, At, B1); PG8_BAR;
            PG8_LDA(At, 1, 1); PG8_STAGE(PG8_SA(1, 0), a3, voffA);
            PG8_BAR; PG8_WAIT_L(0); PG8_MMA(1, 0, At, B0); PG8_BAR; PG8_SCHED;
            PG8_STAGE(PG8_SB(1, 1), b3 + hstep, voffB);
            PG8_WAIT_V(6); PG8_BAR; PG8_MMA(1, 1, At, B1); PG8_BAR;
            }
        }
        if constexpr (ALIGN_EPI) { if (wr == 0) PG8_BAR; }
        if constexpr (!Epi::AFTER_DRAIN) { E(acc, cur, wr, wc, fr, fq); S.done(cur); }
        if (!has_next) break;
#pragma unroll
        for (int a = 0; a < 2; ++a)
#pragma unroll
            for (int b = 0; b < 2; ++b)
#pragma unroll
                for (int m = 0; m < 4; ++m)
#pragma unroll
                    for (int n = 0; n < 2; ++n) acc[a][b][m][n] = (f32x4){0.f, 0.f, 0.f, 0.f};
        cur = nxt; cA = nA; cB = nB; ++ui;
        if constexpr (ALIGN_EPI) { if (wr == 1) PG8_BAR; }
    }
    PG8_WAIT_V(0);
    if constexpr (!ALIGN_EPI) { if (wr == 0) PG8_BAR; }
    PG8_BAR;
    if constexpr (Epi::AFTER_DRAIN) { E.fused(acc, cur, wr, wc, fr, fq, lds, wid, lane); S.done(cur); }
#undef PG8_SA
#undef PG8_SB
#undef PG8_STAGE
#undef PG8_LDA
#undef PG8_LDB
#undef PG8_MMA
#undef PG8_WAIT_V
#undef PG8_WAIT_L
#undef PG8_BAR
#undef PG8_SCHED
}
}


#define GAS __attribute__((address_space(1)))
#define LAS __attribute__((address_space(3)))
typedef unsigned short bf16;
typedef unsigned v4u __attribute__((ext_vector_type(4)));
typedef float f32x4 __attribute__((ext_vector_type(4)));
typedef short bf16x8 __attribute__((ext_vector_type(8)));
typedef GAS unsigned gu32;
typedef GAS unsigned long long gu64;
#define RLX_AGENT __ATOMIC_RELAXED, __HIP_MEMORY_SCOPE_AGENT
#define LDS_WAIT() asm volatile("s_waitcnt lgkmcnt(0)" ::: "memory")
#define VM_WAIT() asm volatile("s_waitcnt vmcnt(0)" ::: "memory")
__device__ __forceinline__ unsigned long long rt() { return __builtin_amdgcn_s_memrealtime(); }
__device__ __forceinline__ unsigned f2bf(float f) { unsigned u = __builtin_bit_cast(unsigned, f); return (u + 0x7fffu + ((u >> 16) & 1u)) >> 16; }
__device__ __forceinline__ unsigned pk2(float lo, float hi) { return f2bf(lo) | (f2bf(hi) << 16); }


#define XB_TMO      128
#define XB_XCNT(j)  (256  + 64 * (j))
#define XB_XSUB(j)  (1280 + 64 * (j))
#define XB_XGEN(j)  (2304 + 64 * (j))
#define XB_TOP      3328
#define XB_TOPGEN   3392
#define XCD_BAR_WORDS 3456
#define XB_SPIN_CAP (1u << 18)

__device__ __forceinline__ unsigned xb_ld(unsigned* p)              { return __hip_atomic_load(p, __ATOMIC_RELAXED, __HIP_MEMORY_SCOPE_AGENT); }
__device__ __forceinline__ unsigned xb_add(unsigned* p, unsigned v) { return __hip_atomic_fetch_add(p, v, __ATOMIC_RELAXED, __HIP_MEMORY_SCOPE_AGENT); }
__device__ __forceinline__ unsigned xb_xcc_id() { return (unsigned)__builtin_amdgcn_s_getreg((3 << 11) | 20) & 0xFu; }
#define XB_SPIN(cond, bar) do { unsigned _sp = 0; while (cond) { __builtin_amdgcn_s_sleep(1); \
    if ((++_sp & 255u) == 0u) { if (xb_ld(&(bar)[XB_TMO])) break; if (_sp > XB_SPIN_CAP) { atomicAdd(&(bar)[XB_TMO], 1u); break; } } } } while (0)

struct XcdBarrier {
    unsigned* bar; unsigned x;
    volatile LAS unsigned* st;
};

__device__ __forceinline__ XcdBarrier xcd_barrier_post(unsigned* bar, volatile LAS unsigned* st) {
    XcdBarrier b; b.bar = bar; b.x = xb_xcc_id(); b.st = st;
    if (threadIdx.x == 0) (void)xb_add(&bar[XB_XCNT(b.x)], 1u);
    return b;
}
__device__ __forceinline__ void xcd_barrier_complete(unsigned* bar, unsigned x, unsigned& nloc, unsigned& nx) {
    const unsigned G = gridDim.x * gridDim.y * gridDim.z;
    unsigned sum, cnt, mine, sp = 0u;
    for (;;) {
        sum = 0u; cnt = 0u; mine = 0u;
#pragma unroll
        for (unsigned j = 0; j < 16; ++j) { const unsigned c = xb_ld(&bar[XB_XCNT(j)]); sum += c; cnt += (c > 0u) ? 1u : 0u; mine = (j == x) ? c : mine; }
        if (sum == G) break;
        __builtin_amdgcn_s_sleep(1);
        if ((++sp & 255u) == 0u) { if (xb_ld(&bar[XB_TMO])) break; if (sp > XB_SPIN_CAP) { atomicAdd(&bar[XB_TMO], 1u); break; } }
    }
    nloc = mine > 0u ? mine : 1u; nx = cnt > 0u ? cnt : 1u;
}

__device__ __forceinline__ void xcd_barrier(const XcdBarrier& b) {
    asm volatile("s_waitcnt vmcnt(0)" ::: "memory");
    __syncthreads();
    if (threadIdx.x == 0) {
        unsigned* bar = b.bar;
        __builtin_amdgcn_s_waitcnt(0);
        unsigned nloc = b.st[0], nx = b.st[1];
        if (nloc == 0u) { xcd_barrier_complete(bar, b.x, nloc, nx); b.st[0] = nloc; b.st[1] = nx; }
        const unsigned old = xb_add(&bar[XB_XSUB(b.x)], 1u);
        const unsigned gen = old / nloc;
        if (old + 1u == (gen + 1u) * nloc) {
            __builtin_amdgcn_fence(__ATOMIC_RELEASE, "agent");
            asm volatile("s_waitcnt vmcnt(0)" ::: "memory");
            const unsigned og = xb_add(&bar[XB_TOP], 1u);
            const unsigned tg = og / nx;
            if (og + 1u == (tg + 1u) * nx) xb_add(&bar[XB_TOPGEN], 1u);
            else XB_SPIN(xb_ld(&bar[XB_TOPGEN]) == tg, bar);
            __builtin_amdgcn_fence(__ATOMIC_ACQUIRE, "agent");
            xb_add(&bar[XB_XGEN(b.x)], 1u);
            asm volatile("s_waitcnt vmcnt(0)" ::: "memory");
        } else {
            XB_SPIN(xb_ld(&bar[XB_XGEN(b.x)]) == gen, bar);
            __builtin_amdgcn_fence(__ATOMIC_ACQUIRE, "agent");
            asm volatile("s_waitcnt vmcnt(0)" ::: "memory");
        }
    }
    __syncthreads();
}


constexpr int NWAVES = 8;
constexpr int BATCH = 2, T = 8192, D = 1024, M = BATCH * T, FF = 4096, NPROJ = 2048;
constexpr float EPS = 1e-6f;
constexpr float C2 = 0.125f * 1.4426950408889634f;
constexpr int N_PHASES = 10;
#ifndef PROBE_PH
#define PROBE_PH -1
#endif
#define NREP(k) ((PROBE_PH == (k)) ? 2 : 1)
#define NREPS(k, a, b) ((PROBE_PH == (k) || PROBE_PH == (a) || PROBE_PH == (b)) ? 2 : 1)
#define PSKIP(rep, sub) ((rep) == 1 && PROBE_PH >= 10 && PROBE_PH != (sub))

constexpr size_t KiB = 1024, MiB = 1u << 20;
constexpr size_t WS_CTL = 0, CTL_ZERO_BYTES = 1 * MiB;
constexpr int CW_TMO = 0, CW_CODE = 1, CW_BAR = 4096;
constexpr size_t Z_MOD = 128 * KiB;
constexpr size_t Z_BIAS1 = 192 * KiB;
constexpr size_t Z_BIAS2 = 224 * KiB;
constexpr size_t Z_SSQS = 256 * KiB, Z_SSQ1 = 320 * KiB, Z_SSQ2 = 384 * KiB;
constexpr size_t Z_KSUM = 512 * KiB;
constexpr size_t Z_LCNT = 640 * KiB;
constexpr size_t WS_ROPE = 2 * MiB;
constexpr size_t WS_SSMP = 4 * MiB;
constexpr size_t WS_SST = 42 * MiB;
constexpr size_t SSM_BF = 0, SSM_CF = 128 * KiB, SSM_AP = 256 * KiB;
constexpr size_t WS_RSTD0 = 5 * MiB;
constexpr size_t WS_WIN = 6 * MiB, WS_WGLU = 14 * MiB, WS_WOUT = 15 * MiB, WS_W1 = 17 * MiB, WS_W2 = 33 * MiB;
constexpr size_t WS_XB = 48 * MiB;
constexpr size_t WS_Q = 80 * MiB, WS_K = 96 * MiB, WS_V = 112 * MiB, WS_U = 128 * MiB;
constexpr size_t WS_MIX = 144 * MiB;
constexpr size_t WS_Y = 176 * MiB;
constexpr size_t WS_H = 80 * MiB;
constexpr size_t WS_PO0 = 48 * MiB;
constexpr size_t WS_PO1 = 224 * MiB;
constexpr size_t WS_PML = 192 * MiB;
constexpr size_t WS_SEL = 196 * MiB;
constexpr size_t WS_LIST = 208 * MiB;
constexpr size_t WS_DUMMY = 44 * MiB, Z_LCNT2 = 648 * KiB;
constexpr size_t WS_END = 256 * MiB;

constexpr int RING_OFF = 0, RING_BYTES = 131072;
constexpr int LDSCTL_OFF = RING_BYTES, MISC_OFF = LDSCTL_OFF + 320;
constexpr int LDS_BYTES = 147456;

struct Frame {
    LAS unsigned char* lds;
    volatile LAS unsigned* MISC;
    gu32* ctl;
    int tid, lane, wave, vcu, G;
};

__device__ __forceinline__ float wave_sum(float v) {
#pragma unroll
    for (int o = 1; o < 64; o <<= 1) v += __shfl_xor(v, o);
    return v;
}

__device__ __forceinline__ int qk_dst(int c) {
    if (c >= 1024) return c;
    const int hb = c & ~63, d = c & 63, dd = d & 31;
    return hb + 8 * (dd >> 2) + (d >> 5) * 4 + (dd & 3);
}
__device__ __forceinline__ void tr_item(const float* W, int N, int ksrc0, int n0, bf16* WT0, bf16* WT1, int ldk, int kdst0,
                                        const float* g, const float* sc0, const float* sc1, const float* sh0, const float* sh1, float* bias0, float* bias1,
                                        int gi0, bool qkperm, LAS float* scr, int lane) {
    { float wv[32];
#pragma unroll
      for (int i = 0; i < 32; ++i) wv[i] = W[(size_t)(ksrc0 + 2 * i + (lane >> 5)) * N + n0 + (lane & 31)];
#pragma unroll
      for (int i = 0; i < 32; ++i) scr[(2 * i + (lane >> 5)) * 33 + (lane & 31)] = wv[i]; }
    LDS_WAIT(); asm volatile("" ::: "memory");
    const int c = lane & 7;
    float s0[8], s1[8];
#pragma unroll
    for (int e = 0; e < 8; ++e) { const int gi = gi0 + 8 * c + e; const float gg = g ? g[gi] : 1.f; s0[e] = sc0 ? gg * (1.f + sc0[gi]) : gg; s1[e] = sc1 ? gg * (1.f + sc1[gi]) : gg; }
#pragma unroll
    for (int j = 0; j < 4; ++j) { const int n = (lane >> 3) + 8 * j; const LAS float* s = scr + (8 * c) * 33 + n;
        float f[8];
#pragma unroll
        for (int e = 0; e < 8; ++e) f[e] = s[e * 33];
        const int dr = qkperm ? qk_dst(n0 + n) : (n0 + n);
        v4u o; o.x = pk2(f[0] * s0[0], f[1] * s0[1]); o.y = pk2(f[2] * s0[2], f[3] * s0[3]); o.z = pk2(f[4] * s0[4], f[5] * s0[5]); o.w = pk2(f[6] * s0[6], f[7] * s0[7]);
        *(GAS v4u*)(WT0 + (size_t)dr * ldk + kdst0 + 8 * c) = o;
        if (WT1) { v4u p; p.x = pk2(f[0] * s1[0], f[1] * s1[1]); p.y = pk2(f[2] * s1[2], f[3] * s1[3]); p.z = pk2(f[4] * s1[4], f[5] * s1[5]); p.w = pk2(f[6] * s1[6], f[7] * s1[7]);
            *(GAS v4u*)(WT1 + (size_t)dr * ldk + kdst0 + 8 * c) = p; } }
    if (bias0) { const int nn = lane & 31, hf = lane >> 5; float p0 = 0.f, p1 = 0.f;
#pragma unroll 8
        for (int i = 0; i < 32; ++i) { const int kk = hf * 32 + i; const float w = scr[kk * 33 + nn]; p0 += sh0[gi0 + kk] * w; p1 += sh1[gi0 + kk] * w; }
        p0 += __shfl_xor(p0, 32); p1 += __shfl_xor(p1, 32);
        if (lane < 32) { const int dr = qkperm ? qk_dst(n0 + nn) : (n0 + nn); atomicAdd(bias0 + dr, p0); atomicAdd(bias1 + dr, p1); } }
    LDS_WAIT(); asm volatile("" ::: "memory");
}
__device__ __forceinline__ void xprep_rows2(const float* x, bf16* XB, float* rstd, int m, int dm, int lane) {
    const GAS f32x4* xr0 = (const GAS f32x4*)(x + (size_t)m * D) + lane; const GAS f32x4* xr1 = (const GAS f32x4*)(x + (size_t)(m + dm) * D) + lane;
    f32x4 v[4], w[4]; float s = 0.f, t = 0.f;
#pragma unroll
    for (int j = 0; j < 4; ++j) { v[j] = xr0[64 * j]; w[j] = xr1[64 * j]; }
#pragma unroll
    for (int j = 0; j < 4; ++j) { s += (v[j].x * v[j].x + v[j].y * v[j].y) + (v[j].z * v[j].z + v[j].w * v[j].w); t += (w[j].x * w[j].x + w[j].y * w[j].y) + (w[j].z * w[j].z + w[j].w * w[j].w); }
    s = wave_sum(s); t = wave_sum(t);
    GAS unsigned long long* o0 = (GAS unsigned long long*)(XB + (size_t)m * D) + lane; GAS unsigned long long* o1 = (GAS unsigned long long*)(XB + (size_t)(m + dm) * D) + lane;
#pragma unroll
    for (int j = 0; j < 4; ++j) { o0[64 * j] = (unsigned long long)pk2(v[j].x, v[j].y) | ((unsigned long long)pk2(v[j].z, v[j].w) << 32); o1[64 * j] = (unsigned long long)pk2(w[j].x, w[j].y) | ((unsigned long long)pk2(w[j].z, w[j].w) << 32); }
    if (lane == 0) { rstd[m] = 1.0f / sqrtf(s * (1.0f / D) + EPS); rstd[m + dm] = 1.0f / sqrtf(t * (1.0f / D) + EPS); }
}
__device__ __forceinline__ void mod_item(const float* c, const float* w_ada, const float* b_ada, float* mod, int it, int lane) {
    const int kc = it / 24, nc = it % 24, n0 = nc * 256 + lane * 4;
    f32x4 a0 = (f32x4){0.f, 0.f, 0.f, 0.f}, a1 = a0;
#pragma unroll 16
    for (int kk = 0; kk < 32; ++kk) { const int k = kc * 32 + kk; const f32x4 w = *(const GAS f32x4*)(w_ada + (size_t)k * 6144 + n0);
        const float c0 = c[k], c1 = c[D + k]; const float s0 = c0 / (1.f + expf(-c0)), s1 = c1 / (1.f + expf(-c1));
        a0 += w * s0; a1 += w * s1; }
    if (kc == 0) { const f32x4 bb = *(const f32x4*)(b_ada + n0); a0 += bb; a1 += bb; }
#pragma unroll
    for (int i = 0; i < 4; ++i) { atomicAdd(mod + n0 + i, a0[i]); atomicAdd(mod + 6144 + n0 + i, a1[i]); }
}


typedef float f32x16 __attribute__((ext_vector_type(16)));
typedef unsigned u32x2v __attribute__((ext_vector_type(2)));
constexpr int SSM_TC = 128, SSM_NCH = T / SSM_TC;
__device__ __forceinline__ int ssm_tau(int rho) { return 16 * ((rho >> 2) & 1) + (rho & 3) + 4 * (rho >> 3); }
struct cpx { float r, i; };
__device__ __forceinline__ cpx cmul(cpx a, cpx b) { return cpx{a.r * b.r - a.i * b.i, a.r * b.i + a.i * b.r}; }
__device__ __forceinline__ cpx cfma(cpx a, cpx x, float br, float bi) { return cpx{fmaf(a.r, x.r, fmaf(-a.i, x.i, br)), fmaf(a.r, x.i, fmaf(a.i, x.r, bi))}; }
__device__ __forceinline__ float gelu_tanh_f(float x) {
    const float z = x * fmaf(0.044715f * x, x, 1.0f) * (-2.0f * 0.7978845608028654f * 1.4426950408889634f);
    return x * __builtin_amdgcn_rcpf(1.0f + __builtin_amdgcn_exp2f(z));
}
__device__ __forceinline__ void ssm_prep(int item, const float* lam_re, const float* lam_im, const float* log_dt, const float* b_re, const float* b_im, const float* c_re, const float* c_im,
                                         bf16* BF, bf16* CF, float* AP) {
    const int idx = item >> 4, n = item & 15, g = idx >> 6, p = idx & 63;
    const double lr = lam_re[idx], li = lam_im[idx], dt = exp((double)log_dt[g]);
    const double br = b_re[(size_t)idx * 16 + n], bi = b_im[(size_t)idx * 16 + n];
    const float cr = c_re[((size_t)g * 16 + n) * 64 + p], ci = c_im[((size_t)g * 16 + n) * 64 + p];
    const double er = exp(lr * dt); const double ar = er * cos(li * dt), ai = er * sin(li * dt);
    const double nr = ar - 1.0, ni = ai, den = lr * lr + li * li; const double fr = (nr * lr + ni * li) / den, fi = (ni * lr - nr * li) / den;
    if (n == 0) { float* ap = AP + (size_t)idx * 8; ap[0] = (float)ar; ap[1] = (float)ai;
        double pr = ar, pi = ai;
#pragma unroll 1
        for (int s = 0; s < 7; ++s) { const double t = pr * pr - pi * pi; pi = 2.0 * pr * pi; pr = t; if (s == 3) { ap[2] = (float)pr; ap[3] = (float)pi; } }
        ap[4] = (float)pr; ap[5] = (float)pi; ap[6] = 0.f; ap[7] = 0.f; }
    const int r32 = p & 31, ctb = 2 * (p >> 5);
    const float vr = (float)(fr * br - fi * bi), vi = (float)(fr * bi + fi * br); const int ln = r32 + 32 * (n >> 3), e = n & 7;
    BF[((size_t)(g * 4 + ctb) * 64 + ln) * 8 + e] = (bf16)f2bf(vr); BF[((size_t)(g * 4 + ctb + 1) * 64 + ln) * 8 + e] = (bf16)f2bf(vi);
#pragma unroll
    for (int part = 0; part < 2; ++part) { const int k = 2 * p + part, ks = k >> 5, fq = (k >> 3) & 3, ee = k & 7;
        CF[((size_t)(g * 4 + ks) * 64 + n + 16 * fq) * 8 + ee] = (bf16)f2bf(part ? -ci : cr); }
}
#define MFMA32(a, b, c) __builtin_amdgcn_mfma_f32_32x32x16_bf16((a), (b), (c), 0, 0, 0)
#define MFMA16(a, b, c) __builtin_amdgcn_mfma_f32_16x16x32_bf16((a), (b), (c), 0, 0, 0)
__device__ __forceinline__ void ssm_stage1(int unit, const bf16* U, const bf16* BF, const float* AP, float* SST, int lane) {
    const int c = unit & 63, g = (unit >> 6) & 31, b = unit >> 11, r32 = lane & 31, hi = lane >> 5;
    bf16x8 bfr[4];
#pragma unroll
    for (int ct = 0; ct < 4; ++ct) bfr[ct] = *(const bf16x8*)(BF + ((size_t)(g * 4 + ct) * 64 + lane) * 8);
    const float* apA = AP + (size_t)(g * 64 + r32) * 8; const float* apB = apA + 32 * 8;
    const cpx aA{apA[0], apA[1]}, a16A{apA[2], apA[3]}, aB{apB[0], apB[1]}, a16B{apB[2], apB[3]};
    const bf16* ub = U + ((size_t)(b * T + c * SSM_TC + ssm_tau(r32))) * 512 + g * 16 + 8 * hi;
    bf16x8 uf[4];
#pragma unroll
    for (int st = 0; st < 4; ++st) uf[st] = *(const bf16x8*)(ub + (size_t)st * 32 * 512);
    cpx sA{0.f, 0.f}, sB{0.f, 0.f};
    const f32x16 z16 = {0.f, 0.f, 0.f, 0.f, 0.f, 0.f, 0.f, 0.f, 0.f, 0.f, 0.f, 0.f, 0.f, 0.f, 0.f, 0.f};
#pragma unroll
    for (int st = 0; st < 4; ++st) {
        const f32x16 d0 = MFMA32(uf[st], bfr[0], z16), d1 = MFMA32(uf[st], bfr[1], z16), d2 = MFMA32(uf[st], bfr[2], z16), d3 = MFMA32(uf[st], bfr[3], z16);
        sA = cmul(a16A, sA); sB = cmul(a16B, sB);
#pragma unroll
        for (int r = 0; r < 16; ++r) { sA = cfma(aA, sA, d0[r], d1[r]); sB = cfma(aB, sB, d2[r], d3[r]); }
    }
    const float pAr = __shfl_xor(sA.r, 32), pAi = __shfl_xor(sA.i, 32), pBr = __shfl_xor(sB.r, 32), pBi = __shfl_xor(sB.i, 32);
    if (hi == 0) { const cpx tA = cmul(a16A, sA), tB = cmul(a16B, sB);
        float* sp = SST + ((size_t)((b * 32 + g) * SSM_NCH + c) * 64) * 2;
        *(float2*)(sp + 2 * r32) = make_float2(tA.r + pAr, tA.i + pAi); *(float2*)(sp + 2 * (32 + r32)) = make_float2(tB.r + pBr, tB.i + pBi); }
}
__device__ __forceinline__ void ssm_stage2(int unit, const bf16* U, const bf16* BF, const bf16* CF, const float* AP, const float* dskip, const float* SST, bf16* Y, LAS unsigned* X, int lane) {
    const int cp = unit & 31, g = (unit >> 5) & 31, b = unit >> 10, c = 2 * cp, r32 = lane & 31, hi = lane >> 5, fr = lane & 15, fq = lane >> 4;
    const float* apA = AP + (size_t)(g * 64 + r32) * 8; const float* apB = apA + 32 * 8;
    const cpx aA{apA[0], apA[1]}, aB{apB[0], apB[1]}, atA{apA[4], apA[5]}, atB{apB[4], apB[5]};
    cpx xA{0.f, 0.f}, xB{0.f, 0.f};
    { const float* sp = SST + ((size_t)((b * 32 + g) * SSM_NCH) * 64) * 2;
      const int nb = (c + 15) >> 4;
#pragma unroll 1
      for (int bt = 0, cc = c - 16 * nb; bt < nb; ++bt, cc += 16) {
          float2 vA[16], vB[16];
#pragma unroll
          for (int k = 0; k < 16; ++k) { const int ii = cc + k >= 0 ? cc + k : 0; vA[k] = *(const float2*)(sp + (size_t)ii * 128 + 2 * r32); vB[k] = *(const float2*)(sp + (size_t)ii * 128 + 2 * (32 + r32)); }
#pragma unroll
          for (int k = 0; k < 16; ++k) { const float z = cc + k >= 0 ? 1.f : 0.f; xA = cfma(atA, xA, vA[k].x * z, vA[k].y * z); xB = cfma(atB, xB, vB[k].x * z, vB[k].y * z); }
      } }
    bf16x8 bfr[4], cfr[4];
#pragma unroll
    for (int ct = 0; ct < 4; ++ct) { bfr[ct] = *(const bf16x8*)(BF + ((size_t)(g * 4 + ct) * 64 + lane) * 8); cfr[ct] = *(const bf16x8*)(CF + ((size_t)(g * 4 + ct) * 64 + lane) * 8); }
    const f32x4 dsk = *(const f32x4*)(dskip + g * 16 + 4 * fq);
    const f32x16 z16 = {0.f, 0.f, 0.f, 0.f, 0.f, 0.f, 0.f, 0.f, 0.f, 0.f, 0.f, 0.f, 0.f, 0.f, 0.f, 0.f};
#pragma unroll 1
    for (int half = 0; half < 2; ++half) {
        const size_t row0 = (size_t)b * T + (size_t)(c + half) * SSM_TC;
        const bf16* ub = U + (row0 + ssm_tau(r32)) * 512 + g * 16 + 8 * hi;
        bf16x8 uf[4]; u32x2v ue[4][2];
#pragma unroll
        for (int st = 0; st < 4; ++st) { uf[st] = *(const bf16x8*)(ub + (size_t)st * 32 * 512);
#pragma unroll
            for (int tl = 0; tl < 2; ++tl) ue[st][tl] = *(const u32x2v*)(U + (row0 + st * 32 + 16 * tl + fr) * 512 + g * 16 + 4 * fq); }
#pragma unroll
        for (int st = 0; st < 4; ++st) {
            const f32x16 d0 = MFMA32(uf[st], bfr[0], z16), d1 = MFMA32(uf[st], bfr[1], z16), d2 = MFMA32(uf[st], bfr[2], z16), d3 = MFMA32(uf[st], bfr[3], z16);
            LAS unsigned* xw = X + (16 * hi) * 68 + r32;
            if (hi == 0) {
#pragma unroll
                for (int r = 0; r < 16; ++r) { xA = cfma(aA, xA, d0[r], d1[r]); xB = cfma(aB, xB, d2[r], d3[r]); xw[r * 68] = pg8::cvt_pk_bf16(xA.r, xA.i); xw[r * 68 + 32] = pg8::cvt_pk_bf16(xB.r, xB.i); }
            }
            { const float mAr = __shfl_xor(xA.r, 32), mAi = __shfl_xor(xA.i, 32), mBr = __shfl_xor(xB.r, 32), mBi = __shfl_xor(xB.i, 32);
              if (hi == 1) { xA = cpx{mAr, mAi}; xB = cpx{mBr, mBi}; } }
            if (hi == 1) {
#pragma unroll
                for (int r = 0; r < 16; ++r) { xA = cfma(aA, xA, d0[r], d1[r]); xB = cfma(aB, xB, d2[r], d3[r]); xw[r * 68] = pg8::cvt_pk_bf16(xA.r, xA.i); xw[r * 68 + 32] = pg8::cvt_pk_bf16(xB.r, xB.i); }
            }
            { const float mAr = __shfl_xor(xA.r, 32), mAi = __shfl_xor(xA.i, 32), mBr = __shfl_xor(xB.r, 32), mBi = __shfl_xor(xB.i, 32);
              if (hi == 0) { xA = cpx{mAr, mAi}; xB = cpx{mBr, mBi}; } }
            asm volatile("s_waitcnt lgkmcnt(0)" ::: "memory");
#pragma unroll
            for (int tl = 0; tl < 2; ++tl) {
                f32x4 acc = {0.f, 0.f, 0.f, 0.f};
#pragma unroll
                for (int ks = 0; ks < 4; ++ks) { const bf16x8 xf = *(const LAS bf16x8*)((const LAS unsigned char*)X + (16 * tl + fr) * 272 + (32 * ks + 8 * fq) * 2); acc = MFMA16(cfr[ks], xf, acc); }
                const size_t row = row0 + st * 32 + 16 * tl + fr;
                const u32x2v uw = ue[st][tl];
                const f32x4 uu = {pg8::bflo(uw.x), pg8::bfhi(uw.x), pg8::bflo(uw.y), pg8::bfhi(uw.y)};
                f32x4 y = acc + dsk * uu;
#pragma unroll
                for (int i = 0; i < 4; ++i) y[i] = gelu_tanh_f(y[i]);
                *(u32x2v*)(Y + row * 512 + g * 16 + 4 * fq) = pg8::pk4(y);
            }
            asm volatile("s_waitcnt lgkmcnt(0)" ::: "memory");
        }
    }
}

typedef short v4i16_t __attribute__((ext_vector_type(4)));
__device__ __forceinline__ void gate_unit(int u, const bf16* Qb, const float* ksum, unsigned* lcnt, unsigned* list, unsigned char* selinfo, LAS float* kl, int tid, int wave, int lane) {
    const int i = u & 31, h = (u >> 5) & 7, b = u >> 8, r32 = lane & 31, hi = lane >> 5;
    const int row = b * T + 256 * i + 32 * wave + r32;
    if (4 * tid < 64 * i) *(LAS f32x4*)(kl + 4 * tid) = *(const f32x4*)(ksum + (size_t)(b * 8 + h) * 2048 + 4 * tid);
    float q[32];
    { const v4u* qp = (const v4u*)(Qb + (size_t)row * 512 + h * 64 + 32 * hi);
#pragma unroll
      for (int c = 0; c < 4; ++c) { const v4u w = qp[c];
          q[8 * c + 0] = pg8::bflo(w.x); q[8 * c + 1] = pg8::bfhi(w.x); q[8 * c + 2] = pg8::bflo(w.y); q[8 * c + 3] = pg8::bfhi(w.y);
          q[8 * c + 4] = pg8::bflo(w.z); q[8 * c + 5] = pg8::bfhi(w.z); q[8 * c + 6] = pg8::bflo(w.w); q[8 * c + 7] = pg8::bfhi(w.w); } }
    __syncthreads();
    float g1 = -INFINITY, g2 = -INFINITY, g3 = -INFINITY; int i1 = -1, i2 = -1, i3 = -1;
    for (int n = 0; n < i; ++n) {
        const LAS f32x4* kp = (const LAS f32x4*)(kl + n * 64 + 32 * hi); float part = 0.f;
#pragma unroll
        for (int c = 0; c < 8; ++c) { const f32x4 kv = kp[c]; part += q[4 * c] * kv.x + q[4 * c + 1] * kv.y + q[4 * c + 2] * kv.z + q[4 * c + 3] * kv.w; }
        const float full = part + __shfl_xor(part, 32);
        if (full > g1) { g3 = g2; i3 = i2; g2 = g1; i2 = i1; g1 = full; i1 = n; }
        else if (full > g2) { g3 = g2; i3 = i2; g2 = full; i2 = n; }
        else if (full > g3) { g3 = full; i3 = n; }
    }
    LAS unsigned* lc = (LAS unsigned*)(kl + 2048); LAS unsigned* lb = lc + 32;
    if (tid < 32) lc[tid] = 0u;
    __syncthreads();
    unsigned p1 = 0u, p2 = 0u, p3 = 0u;
    if (hi == 0) { if (i1 >= 0) p1 = __hip_atomic_fetch_add(lc + i1, 1u, __ATOMIC_RELAXED, __HIP_MEMORY_SCOPE_WORKGROUP); if (i2 >= 0) p2 = __hip_atomic_fetch_add(lc + i2, 1u, __ATOMIC_RELAXED, __HIP_MEMORY_SCOPE_WORKGROUP); if (i3 >= 0) p3 = __hip_atomic_fetch_add(lc + i3, 1u, __ATOMIC_RELAXED, __HIP_MEMORY_SCOPE_WORKGROUP); }
    __syncthreads();
    if (tid < 32) { const unsigned cn = lc[tid]; lb[tid] = cn ? atomicAdd(lcnt + (b * 8 + h) * 32 + tid, cn) : 0u; }
    __syncthreads();
    if (hi == 0) {
        const int nsel = i < 3 ? i : 3; unsigned* lp = list + (size_t)((b * 8 + h) * 32) * 8192;
        if (i1 >= 0) lp[(size_t)i1 * 8192 + lb[i1] + p1] = (unsigned)row | (0u << 16);
        if (i2 >= 0) lp[(size_t)i2 * 8192 + lb[i2] + p2] = (unsigned)row | (1u << 16);
        if (i3 >= 0) lp[(size_t)i3 * 8192 + lb[i3] + p3] = (unsigned)row | (2u << 16);
        selinfo[(size_t)row * 8 + h] = (unsigned char)nsel;
    }
    __syncthreads();
}
constexpr int AT_KOFF = 0, AT_KPITCH = 144, AT_VOFF = 256 * 144, AT_LDS_END = AT_VOFF + 32768;
__device__ __forceinline__ void attn_unit(bool diag, int bh, int j, int q0, int cnt, const unsigned* list, const bf16* Qb, const bf16* Kb, const bf16* Vb,
                                          bf16* PO0, bf16* PO1, float* PML, LAS unsigned char* lds, int tid, int wave, int lane) {
    const int b = bh >> 3, h = bh & 7, r32 = lane & 31, hi = lane >> 5;
    const size_t rowbase = (size_t)b * T + 256 * j;
#pragma unroll
    for (int it = 0; it < 4; ++it) { const int cidx = tid + 512 * it, key = cidx >> 3, ch = cidx & 7;
        const v4u kv = *(const v4u*)(Kb + (rowbase + key) * 512 + h * 64 + ch * 8), vv = *(const v4u*)(Vb + (rowbase + key) * 512 + h * 64 + ch * 8);
        *(LAS v4u*)(lds + AT_KOFF + key * AT_KPITCH + ch * 16) = kv; *(LAS v4u*)(lds + AT_VOFF + (ch >> 2) * 16384 + key * 64 + (ch & 3) * 16) = vv; }
    __syncthreads();
    if (32 * wave < cnt) {
        const int qi = 32 * wave + r32; const bool valid = qi < cnt;
        int row, slot;
        if (diag) { row = (int)rowbase + qi; slot = 3; } else { const unsigned e = list[q0 + (valid ? qi : cnt - 1)]; row = (int)(e & 0xffffu); slot = (int)(e >> 16); }
        bf16x8 qf[4];
#pragma unroll
        for (int d0 = 0; d0 < 4; ++d0) qf[d0] = *(const bf16x8*)(Qb + (size_t)row * 512 + h * 64 + 16 * d0 + 8 * hi);
        const int nkt = diag ? wave + 1 : 8;
        f32x16 sc[8];
        const f32x16 z16 = {0.f, 0.f, 0.f, 0.f, 0.f, 0.f, 0.f, 0.f, 0.f, 0.f, 0.f, 0.f, 0.f, 0.f, 0.f, 0.f};
        float mx = -INFINITY;
#pragma unroll
        for (int kt = 0; kt < 8; ++kt) {
            if (kt < nkt) {
                f32x16 acc = z16;
#pragma unroll
                for (int d0 = 0; d0 < 4; ++d0) { const bf16x8 kf = *(const LAS bf16x8*)(lds + AT_KOFF + (32 * kt + r32) * AT_KPITCH + (16 * d0 + 8 * hi) * 2); acc = MFMA32(kf, qf[d0], acc); }
                if (diag && kt == wave) {
#pragma unroll
                    for (int r = 0; r < 16; ++r) { const int kl = (r & 3) + 8 * (r >> 2) + 4 * hi; if (kl > r32) acc[r] = -INFINITY; }
                }
#pragma unroll
                for (int r = 0; r < 16; ++r) mx = fmaxf(mx, acc[r]);
                sc[kt] = acc;
            } else sc[kt] = z16;
        }
        mx = fmaxf(mx, __shfl_xor(mx, 32));
        float l = 0.f; bf16x8 pb[8][2];
#pragma unroll
        for (int kt = 0; kt < 8; ++kt) {
            if (kt < nkt) {
                float p[16];
#pragma unroll
                for (int r = 0; r < 16; ++r) { p[r] = __builtin_amdgcn_exp2f(sc[kt][r] - mx); l += p[r]; }
#pragma unroll
                for (int s = 0; s < 2; ++s) { v4u w; w.x = pg8::cvt_pk_bf16(p[8 * s], p[8 * s + 1]); w.y = pg8::cvt_pk_bf16(p[8 * s + 2], p[8 * s + 3]); w.z = pg8::cvt_pk_bf16(p[8 * s + 4], p[8 * s + 5]); w.w = pg8::cvt_pk_bf16(p[8 * s + 6], p[8 * s + 7]);
                    pb[kt][s] = __builtin_bit_cast(bf16x8, w); }
            } else { pb[kt][0] = (bf16x8){0, 0, 0, 0, 0, 0, 0, 0}; pb[kt][1] = (bf16x8){0, 0, 0, 0, 0, 0, 0, 0}; }
        }
        l += __shfl_xor(l, 32);
        f32x16 o[2] = {z16, z16};
        const LAS unsigned char* vb = lds + AT_VOFF + (((lane & 15) >> 2) + 4 * hi) * 64 + (16 * ((lane >> 4) & 1) + 4 * (lane & 3)) * 2;
#pragma unroll
        for (int kt = 0; kt < 8; ++kt) {
            if (kt < nkt) {
#pragma unroll
                for (int s = 0; s < 2; ++s)
#pragma unroll
                    for (int dt = 0; dt < 2; ++dt) {
                        const LAS unsigned char* vp = vb + dt * 16384 + (32 * kt + 16 * s) * 64;
                        const v4i16_t lo = __builtin_amdgcn_ds_read_tr16_b64_v4i16((LAS v4i16_t*)vp), hh = __builtin_amdgcn_ds_read_tr16_b64_v4i16((LAS v4i16_t*)(vp + 512));
                        const bf16x8 vf = {lo[0], lo[1], lo[2], lo[3], hh[0], hh[1], hh[2], hh[3]};
                        o[dt] = MFMA32(vf, pb[kt][s], o[dt]);
                    }
            }
        }
        if (valid) {
            const float il = 1.0f / l;
            bf16* po = (slot < 2 ? PO0 : PO1) + (((size_t)row * 8 + h) * 2 + (slot & 1)) * 64;
#pragma unroll
            for (int dt = 0; dt < 2; ++dt)
#pragma unroll
                for (int g4 = 0; g4 < 4; ++g4) { const f32x4 v = {o[dt][4 * g4] * il, o[dt][4 * g4 + 1] * il, o[dt][4 * g4 + 2] * il, o[dt][4 * g4 + 3] * il};
                    *(pg8::u32x2*)(po + 32 * dt + 8 * g4 + 4 * hi) = pg8::pk4(v); }
            if (hi == 0) *(float2*)(PML + (((size_t)row * 8 + h) * 4 + slot) * 2) = make_float2(mx, l);
        }
    }
    __syncthreads();
}
__device__ __forceinline__ void combine_row(int row, const bf16* PO0, const bf16* PO1, const float* PML, const unsigned char* selinfo, bf16* MIX, int lane) {
    const int h = lane >> 3, c8 = lane & 7; const int nsel = selinfo[(size_t)row * 8 + h];
    const float2* ml = (const float2*)(PML + ((size_t)row * 8 + h) * 8);
    float2 m[4];
#pragma unroll
    for (int s = 0; s < 4; ++s) m[s] = ml[s];
    float Mx = m[3].x;
#pragma unroll
    for (int s = 0; s < 3; ++s) if (s < nsel) Mx = fmaxf(Mx, m[s].x);
    float acc[8]; float wsum = 0.f;
#pragma unroll
    for (int e = 0; e < 8; ++e) acc[e] = 0.f;
#pragma unroll
    for (int s = 0; s < 4; ++s) {
        if (s == 3 || s < nsel) { const float w = m[s].y * __builtin_amdgcn_exp2f(m[s].x - Mx); wsum += w;
            const v4u ow = *(const v4u*)((s < 2 ? PO0 : PO1) + (((size_t)row * 8 + h) * 2 + (s & 1)) * 64 + 8 * c8);
            acc[0] += w * pg8::bflo(ow.x); acc[1] += w * pg8::bfhi(ow.x); acc[2] += w * pg8::bflo(ow.y); acc[3] += w * pg8::bfhi(ow.y);
            acc[4] += w * pg8::bflo(ow.z); acc[5] += w * pg8::bfhi(ow.z); acc[6] += w * pg8::bflo(ow.w); acc[7] += w * pg8::bfhi(ow.w); }
    }
    const float iw = 1.0f / wsum; float ss = 0.f;
#pragma unroll
    for (int e = 0; e < 8; ++e) { acc[e] *= iw; ss += acc[e] * acc[e]; }
    ss = wave_sum(ss); const float rs = 1.0f / sqrtf(ss * (1.0f / 512.0f) + EPS);
    const f32x4 a0 = {acc[0] * rs, acc[1] * rs, acc[2] * rs, acc[3] * rs}, a1 = {acc[4] * rs, acc[5] * rs, acc[6] * rs, acc[7] * rs};
    *(pg8::u32x4*)(MIX + (size_t)row * 1024 + 512 + h * 64 + 8 * c8) = pg8::pk8(a0, a1);
}

struct Args { const float* in[23]; float* out; unsigned char* ws; int ph_lo, ph_hi, li, pad; };

__global__ void __launch_bounds__(NWAVES * 64, 2) skel_fwd(Args args) {
    extern __shared__ __attribute__((aligned(16))) unsigned char lds[];
    Frame F;
    F.lds = (LAS unsigned char*)lds;
    F.MISC = (volatile LAS unsigned*)(F.lds + MISC_OFF);
    F.tid = threadIdx.x; F.lane = F.tid & 63; F.wave = __builtin_amdgcn_readfirstlane(F.tid >> 6);
    F.G = gridDim.x; { const int bx = blockIdx.x; F.vcu = (F.G % 8 == 0) ? (bx % 8) * (F.G / 8) + bx / 8 : bx; }
    unsigned char* ws = args.ws;
    F.ctl = (gu32*)(ws + WS_CTL);
    const float* x = args.in[0]; const float* cvec = args.in[1]; const float* w_ada = args.in[2]; const float* b_ada = args.in[3]; const float* g_mix = args.in[4];
    const float* w_in = args.in[5]; const float* g_attn = args.in[6]; const float* w_glu = args.in[15]; const float* b_glu = args.in[16]; const float* g_ssm = args.in[17];
    const float* w_out = args.in[18]; const float* g_mlp = args.in[19]; const float* w_fc1 = args.in[20]; const float* w_fc2 = args.in[21]; const float* g_final = args.in[22];
    const float* lam_re = args.in[7]; const float* lam_im = args.in[8]; const float* log_dt = args.in[9]; const float* b_re = args.in[10]; const float* b_im = args.in[11];
    const float* c_re = args.in[12]; const float* c_im = args.in[13]; const float* d_skip = args.in[14];
    float* out = args.out;
    float* mod = (float*)(ws + Z_MOD); float* bias1 = (float*)(ws + Z_BIAS1); float* bias2 = (float*)(ws + Z_BIAS2);
    float* ssqs = (float*)(ws + Z_SSQS); float* ssq1 = (float*)(ws + Z_SSQ1); float* ssq2 = (float*)(ws + Z_SSQ2); float* ksum = (float*)(ws + Z_KSUM);
    float* rope = (float*)(ws + WS_ROPE); float* rstd0 = (float*)(ws + WS_RSTD0);
    bf16* WinT = (bf16*)(ws + WS_WIN); bf16* WgluT = (bf16*)(ws + WS_WGLU); bf16* WoutT = (bf16*)(ws + WS_WOUT); bf16* W1T = (bf16*)(ws + WS_W1); bf16* W2T = (bf16*)(ws + WS_W2);
    bf16* XB = (bf16*)(ws + WS_XB); bf16* Qb = (bf16*)(ws + WS_Q); bf16* Kb = (bf16*)(ws + WS_K); bf16* Vb = (bf16*)(ws + WS_V); bf16* Ub = (bf16*)(ws + WS_U);
    bf16* MIX = (bf16*)(ws + WS_MIX); bf16* Yb = (bf16*)(ws + WS_Y); bf16* Hb = (bf16*)(ws + WS_H);
    unsigned* lcnt = (unsigned*)(ws + Z_LCNT); unsigned* list = (unsigned*)(ws + WS_LIST); unsigned char* selinfo = ws + WS_SEL; float* PML = (float*)(ws + WS_PML);
    bf16* PO0 = (bf16*)(ws + WS_PO0); bf16* PO1 = (bf16*)(ws + WS_PO1);
    bf16* BF = (bf16*)(ws + WS_SSMP + SSM_BF); bf16* CF = (bf16*)(ws + WS_SSMP + SSM_CF); float* AP = (float*)(ws + WS_SSMP + SSM_AP); float* SST = (float*)(ws + WS_SST);

    for (int u = F.tid; u < (LDS_BYTES - LDSCTL_OFF) / 4; u += NWAVES * 64) ((LAS unsigned*)(F.lds + LDSCTL_OFF))[u] = 0u;
    __syncthreads();
    XcdBarrier bar = xcd_barrier_post((unsigned*)(F.ctl + CW_BAR) + args.li * XCD_BAR_WORDS, F.MISC + 8);
#define GRID_BAR() xcd_barrier(bar)
    const int lo = args.ph_lo, hi = args.ph_hi;
#define IN(k) (lo <= (k) && (k) < hi)
#define BOTH(k) (IN(k) && IN((k) + 1))
    const int gw = F.vcu * NWAVES + F.wave, NGW = F.G * NWAVES;
    LAS float* scr = (LAS float*)(F.lds + RING_OFF + F.wave * 16384);

    float* dummyf = (float*)(ws + WS_DUMMY);
    if (IN(0)) {
      for (int rep = 0; rep < NREP(0); ++rep) {
        for (int it = gw; it < 768; it += NGW) mod_item(cvec, w_ada, b_ada, rep ? dummyf : mod, it, F.lane);
        constexpr int I_GLU = 8 * 16, I_OUT = 2 * 8 * 32, I_W2 = 64 * 32, I_ALL = I_GLU + I_OUT + I_W2;
        for (int it0 = gw; it0 < I_ALL; it0 += NGW) {
            int it = (it0 + 768) % I_ALL;
            if (it < I_GLU) { const int kb = it / 16, nb = it % 16; tr_item(w_glu, 512, 64 * kb, 32 * nb, WgluT, nullptr, 512, 64 * kb, nullptr, nullptr, nullptr, nullptr, nullptr, nullptr, nullptr, 0, false, scr, F.lane); continue; }
            it -= I_GLU;
            if (it < I_OUT) { const int hf = it / 256, r = it % 256, kb = r / 32, nb = r % 32;
                if (hf == 0) tr_item(w_out, 1024, 512 + 64 * kb, 32 * nb, WoutT, nullptr, 1024, 64 * kb, g_ssm, nullptr, nullptr, nullptr, nullptr, nullptr, nullptr, 64 * kb, false, scr, F.lane);
                else         tr_item(w_out, 1024, 64 * kb, 32 * nb, WoutT, nullptr, 1024, 512 + 64 * kb, g_attn, nullptr, nullptr, nullptr, nullptr, nullptr, nullptr, 64 * kb, false, scr, F.lane);
                continue; }
            it -= I_OUT;
            { const int kb = it / 32, nb = it % 32; tr_item(w_fc2, 1024, 64 * kb, 32 * nb, W2T, nullptr, 4096, 64 * kb, nullptr, nullptr, nullptr, nullptr, nullptr, nullptr, nullptr, 0, false, scr, F.lane); }
        }
        for (int idx = blockIdx.x * (NWAVES * 64) + F.tid; idx < T * 32; idx += F.G * NWAVES * 64) { const int t = idx >> 5, d = idx & 31;
            const float inv = powf(10000.f, -(float)d / 32.f); const float ang = (float)t * inv; const float sn = sinf(ang), cs = cosf(ang);
            float* rp = rope + ((size_t)t * 8 + (d >> 2)) * 8 + (d & 3); rp[0] = cs; rp[4] = sn; }
        if (F.tid < 128) { const int item = blockIdx.x * 128 + F.tid; if (item < 32 * 64 * 16) ssm_prep(item, lam_re, lam_im, log_dt, b_re, b_im, c_re, c_im, BF, CF, AP); }
        for (int m = gw; m < M; m += 2 * NGW) xprep_rows2(x, XB, rstd0, m, NGW, F.lane);
      }
        if (BOTH(0)) GRID_BAR();
    }
    if (IN(1)) {
        constexpr int I_IN = 16 * 64, I_W1 = 16 * 128;
        const float *sh1 = mod, *sc1 = mod + D, *sh2 = mod + 3 * D, *sc2 = mod + 4 * D;
      for (int rep = 0; rep < NREP(1); ++rep) {
        float* b1p = rep ? dummyf : bias1; float* b2p = rep ? dummyf + 8192 : bias2;
        for (int it0 = gw; it0 < I_IN + I_W1; it0 += NGW) {
            int it = it0;
            if (it < I_IN) { const int kb = it / 64, nb = it % 64;
                tr_item(w_in, NPROJ, 64 * kb, 32 * nb, WinT, WinT + (size_t)NPROJ * D, D, 64 * kb, g_mix, sc1, sc1 + 6144, sh1, sh1 + 6144, b1p, b1p + NPROJ, 64 * kb, true, scr, F.lane); continue; }
            it -= I_IN;
            { const int kb = it / 128, nb = it % 128;
                tr_item(w_fc1, FF, 64 * kb, 32 * nb, W1T, W1T + (size_t)FF * D, D, 64 * kb, g_mlp, sc2, sc2 + 6144, sh2, sh2 + 6144, b2p, b2p + FF, 64 * kb, false, scr, F.lane); }
        }
      }
        if (BOTH(1)) GRID_BAR();
    }
    if (IN(2)) {
        pg8::Gemm g{XB, WinT, M, NPROJ, D, (size_t)NPROJ * D * 2, -1}; pg8::StaticOrder S; S.init(M, NPROJ, F.G, (int)blockIdx.x);
        for (int rep = 0; rep < NREP(2); ++rep) {
        pg8::EpiProj E{rstd0, bias1, rope, Qb, Kb, Vb, Ub, rep ? dummyf : ksum, C2};
        pg8::gemm_phase<pg8::EpiProj, pg8::StaticOrder, true, true>(F.lds + RING_OFF, g, S, E); }
        if (BOTH(2)) GRID_BAR();
    }
    if (IN(3)) {
        for (int rep = 0; rep < NREPS(3, 30, 31); ++rep) {
        if (!PSKIP(rep, 30)) for (int u = gw; u < 2 * 32 * SSM_NCH; u += NGW) ssm_stage1(u, Ub, BF, AP, SST, F.lane);
        __syncthreads();
        if (!PSKIP(rep, 31)) for (int k = blockIdx.x; k < 256; k += F.G)
            for (int hf = 0; hf < 2; ++hf) gate_unit(hf ? 511 - k : k, Qb, ksum, rep ? (unsigned*)(ws + Z_LCNT2) : lcnt, rep ? (unsigned*)(ws + WS_PO1) : list, selinfo, (LAS float*)(F.lds + RING_OFF), F.tid, F.wave, F.lane); }
        if (BOTH(3)) GRID_BAR();
    }
    if (IN(4)) {
      for (int rep = 0; rep < NREPS(4, 40, 41); ++rep) {
        if (!PSKIP(rep, 40)) for (int u = gw; u < 2 * 32 * (SSM_NCH / 2); u += NGW) ssm_stage2(u, Ub, BF, CF, AP, d_skip, SST, Yb, (LAS unsigned*)(F.lds + RING_OFF + F.wave * 16384), F.lane);
        __syncthreads();
        if (!PSKIP(rep, 41)) {
            LAS int* pre = (LAS int*)(F.lds + 120 * 1024);
            if (F.tid < 512) pre[F.tid] = (int)((lcnt[F.tid] + 255u) >> 8);
            __syncthreads();
            if (F.tid == 0) { int s = 0; for (int k = 0; k < 512; ++k) { const int v = pre[k]; pre[k] = s; s += v; } pre[512] = s; }
            __syncthreads();
            const int total = 512 + pre[512];
            for (int u = blockIdx.x; u < total; u += F.G) {
                if (u < 512) { attn_unit(true, u >> 5, u & 31, 0, 256, nullptr, Qb, Kb, Vb, PO0, PO1, PML, F.lds, F.tid, F.wave, F.lane); }
                else { const int v = u - 512; int lo_ = 0, hi_ = 511;
                    while (lo_ < hi_) { const int mid = (lo_ + hi_ + 1) >> 1; if (pre[mid] <= v) lo_ = mid; else hi_ = mid - 1; }
                    const int chunk = v - pre[lo_]; const int cn = (int)lcnt[lo_] - 256 * chunk;
                    attn_unit(false, lo_ >> 5, lo_ & 31, 256 * chunk, cn < 256 ? cn : 256, list + (size_t)lo_ * 8192, Qb, Kb, Vb, PO0, PO1, PML, F.lds, F.tid, F.wave, F.lane); }
            }
        }
        __syncthreads();
      }
        if (BOTH(4)) GRID_BAR();
    }
    if (IN(5)) {
        for (int rep = 0; rep < NREP(5); ++rep) {
        for (int m = gw; m < M; m += NGW) combine_row(m, PO0, PO1, PML, selinfo, MIX, F.lane);
        pg8::Gemm g{Yb, WgluT, M, 512, 512, 0, -1}; pg8::StaticOrder S; S.init(M, 512, F.G, (int)blockIdx.x);
        pg8::EpiGlu E{Yb, b_glu, MIX, rep ? dummyf : ssqs};
        pg8::gemm_phase<pg8::EpiGlu, pg8::StaticOrder, false, true>(F.lds + RING_OFF, g, S, E); }
        if (BOTH(5)) GRID_BAR();
    }
    if (IN(6)) {
        pg8::Gemm g{MIX, WoutT, M, D, D, 0, 8}; pg8::StaticOrder S; S.init(M, D, F.G, (int)blockIdx.x);
        for (int rep = 0; rep < NREP(6); ++rep) {
        pg8::EpiOut E{x, mod + 2 * D, out, XB, rep ? dummyf : ssq1, ssqs};
        pg8::gemm_phase<pg8::EpiOut, pg8::StaticOrder, false, true>(F.lds + RING_OFF, g, S, E); }
        if (BOTH(6)) GRID_BAR();
    }
    if (IN(7)) {
        pg8::Gemm g{XB, W1T, M, FF, D, (size_t)FF * D * 2, -1}; pg8::StaticOrder S; S.init(M, FF, F.G, (int)blockIdx.x);
        pg8::EpiFc1 E{ssq1, bias2, Hb};
        for (int rep = 0; rep < NREP(7); ++rep)
        pg8::gemm_phase<pg8::EpiFc1, pg8::StaticOrder, true, true>(F.lds + RING_OFF, g, S, E);
        if (BOTH(7)) GRID_BAR();
    }
    if (IN(8)) {
        pg8::Gemm g{Hb, W2T, M, D, FF, 0, -1}; pg8::StaticOrder S; S.init(M, D, F.G, (int)blockIdx.x);
        for (int rep = NREP(8) - 1; rep >= 0; --rep) {
        pg8::EpiFc2 E{mod + 5 * D, out, rep ? (float*)(ws + WS_XB) : out, rep ? (size_t)0x7fffff : ~(size_t)0, rep ? dummyf : ssq2};
        pg8::gemm_phase<pg8::EpiFc2, pg8::StaticOrder, false, true>(F.lds + RING_OFF, g, S, E); }
        if (BOTH(8)) GRID_BAR();
    }
    if (IN(9)) {
        for (int rep = NREP(9) - 1; rep >= 0; --rep)
        for (int m = gw; m < M; m += NGW) { GAS f32x4* o = (GAS f32x4*)(out + (size_t)m * D) + F.lane; GAS f32x4* w = rep ? (GAS f32x4*)((float*)(ws + WS_XB) + (size_t)(m & 8191) * D) + F.lane : o;
            const float rs = 1.0f / sqrtf(ssq2[m] * (1.0f / D) + EPS);
#pragma unroll
            for (int j = 0; j < 4; ++j) { const f32x4 gg = *(const f32x4*)(g_final + 4 * F.lane + 256 * j); w[64 * j] = o[64 * j] * rs * gg; } }
    }
#undef IN
#undef BOTH
#undef GRID_BAR
}

extern "C" void kernel_launch(void* const* d_in, const int* in_sizes, int n_in, void* d_out, int out_size, void* d_ws, size_t ws_size, hipStream_t stream) {
    static int grid = 0;
    if (grid == 0) {
        if (n_in != 23 || in_sizes[0] != M * D || out_size != M * D || ws_size < WS_END) { fprintf(stderr, "kernel_launch: unexpected shapes (n_in %d, in0 %d, out %d, ws %zu)\n", n_in, n_in > 0 ? in_sizes[0] : -1, out_size, ws_size); grid = -1; return; }
        int dev = 0, cus = 0, per_cu = 0;
        if (hipGetDevice(&dev) != hipSuccess || hipDeviceGetAttribute(&cus, hipDeviceAttributeMultiprocessorCount, dev) != hipSuccess) { grid = -1; return; }
        if (hipFuncSetAttribute((const void*)skel_fwd, hipFuncAttributeMaxDynamicSharedMemorySize, LDS_BYTES) != hipSuccess) { fprintf(stderr, "kernel_launch: hipFuncSetAttribute failed\n"); grid = -1; return; }
        if (hipOccupancyMaxActiveBlocksPerMultiprocessor(&per_cu, (const void*)skel_fwd, NWAVES * 64, LDS_BYTES) != hipSuccess || per_cu < 1) { fprintf(stderr, "kernel_launch: occupancy query says %d\n", per_cu); per_cu = 1; }
        (void)hipGetLastError();
        grid = cus;
        if (grid != 256) fprintf(stderr, "kernel_launch: %d CUs (expected 256)\n", grid);
    }
    if (grid < 0) return;
    (void)hipMemsetAsync((char*)d_ws + WS_CTL, 0, CTL_ZERO_BYTES, stream);
    Args a{};
    for (int i = 0; i < 23; ++i) a.in[i] = (const float*)d_in[i];
    a.out = (float*)d_out; a.ws = (unsigned char*)d_ws;
    a.ph_lo = 0; a.ph_hi = N_PHASES; a.li = 0;
    hipLaunchKernelGGL(skel_fwd, dim3(grid), dim3(NWAVES * 64), LDS_BYTES, stream, a);
}
```
